# Optimizing an MI355X kernel written in HIP

```python
import math
import jax, jax.numpy as jnp
from jax import lax
import numpy as np

D_MODEL = 2048
BATCH = 4
SEQ = 2048
DEPTH = 2

CHUNK = 64

CONV_WIDTH = D_MODEL
CONV_K = 3
SSM_WIDTH = D_MODEL // 2
SSM_GROUP = 16
SSM_GROUPS = SSM_WIDTH // SSM_GROUP
SSM_STATE = 64
DT_MIN = 0.001
DT_MAX = 0.1
RMS_EPS = 1e-6

_SIZES = (CONV_WIDTH, CONV_WIDTH, CONV_WIDTH, CONV_WIDTH,
          SSM_WIDTH, SSM_WIDTH,
          D_MODEL, D_MODEL)
N_IN = int(sum(_SIZES))
SPLITS = tuple(int(s) for s in np.cumsum(_SIZES)[:-1])

kernel_name = "hybrid_conv_s5_gated_encoder"


def rmsnorm(x, g):
    x32 = x.astype(jnp.float32)
    y = x32 * lax.rsqrt(jnp.mean(x32 * x32, axis=-1, keepdims=True) + RMS_EPS)
    return (y * g.astype(jnp.float32)).astype(x.dtype)


def causal_depthwise_conv(v, w):
    L = v.shape[1]
    vp = jnp.pad(v, ((0, 0), (CONV_K - 1, 0), (0, 0)))
    out = w[0] * vp[:, 0:L]
    for k in range(1, CONV_K):
        out = out + w[k] * vp[:, k:k + L]
    return out


def s5_scan(u, a_re, a_im, log_dt, b_re, b_im, c_re, c_im, d_skip):
    bsz, L, _ = u.shape
    f32 = jnp.float32
    ug = u.astype(f32).reshape(bsz, L, SSM_GROUPS, SSM_GROUP)
    lam = lax.complex(a_re.astype(f32), a_im.astype(f32))
    dt = jnp.exp(log_dt.astype(f32))[:, None]
    lam_bar = jnp.exp(lam * dt)
    b = lax.complex(b_re.astype(f32), b_im.astype(f32))
    b_bar = ((lam_bar - 1.0) / lam)[..., None] * b
    bu = jnp.einsum('gpc,blgc->blgp', b_bar, ug.astype(jnp.complex64))
    a = jnp.broadcast_to(lam_bar, bu.shape)

    def combine(e1, e2):
        a1, h1 = e1
        a2, h2 = e2
        return a1 * a2, a2 * h1 + h2

    _, h = lax.associative_scan(combine, (a, bu), axis=1)
    c = lax.complex(c_re.astype(f32), c_im.astype(f32))
    y = jnp.einsum('gcp,blgp->blgc', c, h).real + d_skip.astype(f32) * ug
    return y.reshape(bsz, L, SSM_WIDTH)


def hybrid_layer(x, norm_g, w_in, conv_w, w_out_a, a_re, a_im, log_dt, b_re, b_im,
                 c_re, c_im, d_skip, w_glu, b_glu, w_out_b, w_o):
    h = rmsnorm(x, norm_g)
    proj = jnp.einsum('bld,dn->bln', h, w_in)
    v, bg, cg, za, u, zb, ga, gb = jnp.split(proj, SPLITS, axis=-1)
    ya = bg * causal_depthwise_conv(cg * v, conv_w)
    ya = jnp.einsum('blc,cd->bld', ya * jax.nn.silu(za), w_out_a)
    yb = jax.nn.gelu(s5_scan(u, a_re, a_im, log_dt, b_re, b_im, c_re, c_im, d_skip))
    yb = yb * jax.nn.sigmoid(jnp.einsum('blc,ce->ble', yb, w_glu.astype(jnp.float32))
                             + b_glu.astype(jnp.float32))
    yb = yb.astype(x.dtype)
    yb = jnp.einsum('blc,cd->bld', yb * jax.nn.silu(zb), w_out_b)
    m = jax.nn.sigmoid(ga) * ya + jax.nn.sigmoid(gb) * yb
    return x + jnp.einsum('bld,de->ble', m, w_o)


def setup_inputs(seed: int = 0) -> dict:
    key = jax.random.key(seed)
    ks = jax.random.split(key, 20)
    f32 = jnp.float32
    n = lambda k, shape, s: jax.random.normal(k, shape, f32) * s
    res_scale = 1.0 / math.sqrt(2.0 * DEPTH)
    G, P, c = SSM_GROUPS, SSM_STATE, SSM_GROUP
    a_im_base = math.pi * jnp.arange(P, dtype=f32)
    return {
        "x": n(ks[0], (BATCH, SEQ, D_MODEL), 1.0),
        "norm_g": 1.0 + n(ks[1], (DEPTH, D_MODEL), 0.02),
        "w_in": n(ks[2], (DEPTH, D_MODEL, N_IN), D_MODEL ** -0.5),
        "conv_w": n(ks[3], (DEPTH, CONV_K, CONV_WIDTH), CONV_K ** -0.5),
        "w_out_a": n(ks[4], (DEPTH, CONV_WIDTH, D_MODEL), CONV_WIDTH ** -0.5),
        "a_re": -0.5 + n(ks[5], (DEPTH, G, P), 0.01),
        "a_im": a_im_base + n(ks[6], (DEPTH, G, P), 0.01),
        "log_dt": jax.random.uniform(ks[7], (DEPTH, G), f32,
                                     math.log(DT_MIN), math.log(DT_MAX)),
        "b_re": n(ks[8], (DEPTH, G, P, c), (2.0 * c) ** -0.5),
        "b_im": n(ks[9], (DEPTH, G, P, c), (2.0 * c) ** -0.5),
        "c_re": n(ks[10], (DEPTH, G, c, P), (2.0 * P) ** -0.5),
        "c_im": n(ks[11], (DEPTH, G, c, P), (2.0 * P) ** -0.5),
        "d_skip": n(ks[12], (DEPTH, G, c), 1.0),
        "w_glu": n(ks[13], (DEPTH, SSM_WIDTH, SSM_WIDTH), SSM_WIDTH ** -0.5),
        "b_glu": n(ks[14], (DEPTH, SSM_WIDTH), 0.02),
        "w_out_b": n(ks[15], (DEPTH, SSM_WIDTH, D_MODEL), SSM_WIDTH ** -0.5),
        "w_o": n(ks[16], (DEPTH, D_MODEL, D_MODEL), D_MODEL ** -0.5 * res_scale),
        "final_g": 1.0 + n(ks[17], (D_MODEL,), 0.02),
    }


def reference(x, norm_g, w_in, conv_w, w_out_a, a_re, a_im, log_dt, b_re, b_im,
              c_re, c_im, d_skip, w_glu, b_glu, w_out_b, w_o, final_g):
    for i in range(DEPTH):
        x = hybrid_layer(x, norm_g[i], w_in[i], conv_w[i], w_out_a[i], a_re[i], a_im[i],
                         log_dt[i], b_re[i], b_im[i], c_re[i], c_im[i], d_skip[i],
                         w_glu[i], b_glu[i], w_out_b[i], w_o[i])
    return rmsnorm(x, final_g)
```

```cpp
#include <hip/hip_runtime.h>
#include <hip/hip_cooperative_groups.h>
#include <cstdio>
#include <cstdint>
namespace cg = cooperative_groups;

#ifndef MK_MULTI
#define MK_MULTI 0
#endif
#ifndef MK_XCDBAR
#define MK_XCDBAR 1
#endif

#define LAS __attribute__((address_space(3)))
typedef unsigned short bf16_t;
typedef short bf16x8 __attribute__((ext_vector_type(8)));
typedef float f32x4 __attribute__((ext_vector_type(4)));
typedef float f32x2 __attribute__((ext_vector_type(2)));
typedef unsigned u32x4 __attribute__((ext_vector_type(4)));
typedef unsigned u32x2 __attribute__((ext_vector_type(2)));

constexpr int DM = 2048, NB = 4, SEQ = 2048, MTOK = NB * SEQ, DEPTH = 2;
constexpr int NIN = 14336, CW = 2048, SW = 1024, SG = 64, SGC = 16, SP = 64;
constexpr int CHUNK = 256, NCHUNK = SEQ / CHUNK;
constexpr float RMS_EPS = 1e-6f;
constexpr int NWAVES = 8, NTHREADS = 512;
constexpr int LDS_STAGE = 131072, LDS_BYTES = LDS_STAGE + 16;

constexpr size_t AL(size_t x) { return (x + 255) & ~(size_t)255; }
constexpr size_t WS_CTL   = 0;
constexpr size_t CTL_BYTES = 16384;
constexpr size_t WS_SS    = WS_CTL + CTL_BYTES;
constexpr size_t WS_LAMB  = AL(WS_SS + (size_t)3 * MTOK * 4);
constexpr size_t WS_LAMT  = AL(WS_LAMB + (size_t)DEPTH * SG * SP * 8);
constexpr size_t WS_BF    = AL(WS_LAMT + (size_t)DEPTH * SG * SP * 8);
constexpr size_t WS_CF    = AL(WS_BF + (size_t)DEPTH * SG * 8 * 64 * 16);
constexpr size_t WS_WIN   = AL(WS_CF + (size_t)DEPTH * SG * 4 * 64 * 16);
constexpr size_t WS_WA    = AL(WS_WIN + (size_t)DEPTH * NIN * DM * 2);
constexpr size_t WS_WGLU  = AL(WS_WA + (size_t)DEPTH * DM * CW * 2);
constexpr size_t WS_WB    = AL(WS_WGLU + (size_t)DEPTH * SW * SW * 2);
constexpr size_t WS_WO    = AL(WS_WB + (size_t)DEPTH * DM * SW * 2);
constexpr size_t WS_XB    = AL(WS_WO + (size_t)DEPTH * DM * DM * 2);
constexpr size_t WS_CV    = AL(WS_XB + (size_t)MTOK * DM * 2);
constexpr size_t WS_GATE  = AL(WS_CV + (size_t)MTOK * CW * 2);
constexpr size_t WS_AIN   = AL(WS_GATE + (size_t)MTOK * CW * 2);
constexpr size_t WS_U     = AL(WS_AIN + (size_t)MTOK * CW * 2);
constexpr size_t WS_SZB   = AL(WS_U + (size_t)DEPTH * MTOK * SW * 4);
constexpr size_t WS_SGA   = AL(WS_SZB + (size_t)MTOK * SW * 2);
constexpr size_t WS_SGB   = AL(WS_SGA + (size_t)MTOK * DM * 2);
constexpr size_t WS_ST    = AL(WS_SGB + (size_t)MTOK * DM * 2);
constexpr size_t WS_GLUIN = AL(WS_ST + (size_t)NB * SG * NCHUNK * SP * 8);
constexpr size_t WS_BIN   = AL(WS_GLUIN + (size_t)MTOK * SW * 2);
constexpr size_t WS_MA    = AL(WS_BIN + (size_t)MTOK * SW * 2);
constexpr size_t WS_M     = AL(WS_MA + (size_t)MTOK * DM * 2);
constexpr size_t WS_X1    = AL(WS_M + (size_t)MTOK * DM * 2);
constexpr size_t WS_END   = AL(WS_X1 + (size_t)MTOK * DM * 4);

typedef __bf16 bf16x2v __attribute__((ext_vector_type(2)));
__device__ __forceinline__ unsigned cvt_pk_bf16(float lo, float hi) { const f32x2 v = {lo, hi}; return __builtin_bit_cast(unsigned, __builtin_convertvector(v, bf16x2v)); }
__device__ __forceinline__ f32x4 ld_bf16x4(const bf16_t* p) { const u32x2 w = *(const u32x2*)p; f32x4 r; r.x = __uint_as_float(w.x << 16); r.y = __uint_as_float(w.x & 0xffff0000u); r.z = __uint_as_float(w.y << 16); r.w = __uint_as_float(w.y & 0xffff0000u); return r; }
__device__ __forceinline__ void st_bf16x4(bf16_t* p, f32x4 v) { u32x2 w; w.x = cvt_pk_bf16(v.x, v.y); w.y = cvt_pk_bf16(v.z, v.w); *(u32x2*)p = w; }
struct F8 { f32x4 lo, hi; };
__device__ __forceinline__ F8 ld_bf16x8(const bf16_t* p) { const u32x4 w = *(const u32x4*)p; F8 r;
    r.lo = (f32x4){__uint_as_float(w.x << 16), __uint_as_float(w.x & 0xffff0000u), __uint_as_float(w.y << 16), __uint_as_float(w.y & 0xffff0000u)};
    r.hi = (f32x4){__uint_as_float(w.z << 16), __uint_as_float(w.z & 0xffff0000u), __uint_as_float(w.w << 16), __uint_as_float(w.w & 0xffff0000u)}; return r; }
__device__ __forceinline__ void st_bf16x8(bf16_t* p, f32x4 a, f32x4 b) { u32x4 w; w.x = cvt_pk_bf16(a.x, a.y); w.y = cvt_pk_bf16(a.z, a.w); w.z = cvt_pk_bf16(b.x, b.y); w.w = cvt_pk_bf16(b.z, b.w); *(u32x4*)p = w; }
__device__ __forceinline__ float sigmoidf_(float x) { return __builtin_amdgcn_rcpf(1.0f + __expf(-x)); }
__device__ __forceinline__ float siluf_(float x) { return x * __builtin_amdgcn_rcpf(1.0f + __expf(-x)); }
__device__ __forceinline__ float geluf_(float x) { const float z = 0.7978845608028654f * (x + 0.044715f * x * x * x); const float t = 1.0f - 2.0f * __builtin_amdgcn_rcpf(1.0f + __expf(2.0f * z)); return 0.5f * x * (1.0f + t); }
__device__ __forceinline__ f32x4 sig4(f32x4 v) { f32x4 r; r.x = sigmoidf_(v.x); r.y = sigmoidf_(v.y); r.z = sigmoidf_(v.z); r.w = sigmoidf_(v.w); return r; }
__device__ __forceinline__ f32x4 silu4(f32x4 v) { f32x4 r; r.x = siluf_(v.x); r.y = siluf_(v.y); r.z = siluf_(v.z); r.w = siluf_(v.w); return r; }
__device__ __forceinline__ float wave_sum(float v) {
#pragma unroll
    for (int o = 1; o < 64; o <<= 1) v += __shfl_xor(v, o);
    return v;
}
template <int CTRL> __device__ __forceinline__ float dppf(float x) { return __builtin_bit_cast(float, __builtin_amdgcn_update_dpp(0, __builtin_bit_cast(int, x), CTRL, 0xf, 0xf, true)); }
template <int CTRL> __device__ __forceinline__ f32x4 dpp4(f32x4 v) { f32x4 r; r.x = dppf<CTRL>(v.x); r.y = dppf<CTRL>(v.y); r.z = dppf<CTRL>(v.z); r.w = dppf<CTRL>(v.w); return r; }
#define LDS_WAIT() asm volatile("s_waitcnt lgkmcnt(0)" ::: "memory")

namespace pg8 {
constexpr int BM = 256, BK = 64, HALF = 128, HTB = HALF * BK * 2, STAGE_BYTES = 8 * HTB, NXCD = 8, WGM = 4;
__host__ __device__ __forceinline__ int lds_byte(int r, int c) { const int st = (r >> 4) * 2 + (c >> 5), rr = r & 15, cc = c & 31, ob = rr * 64 + cc * 2; return st * 1024 + (ob ^ (((ob >> 9) & 1) << 5)); }
__host__ __device__ __forceinline__ void stage_rc(int b, int& R, int& C) { const int st = b / 1024, sb = b % 1024, swz = sb ^ (((sb >> 9) & 1) << 5); R = (st >> 1) * 16 + swz / 64; C = (st & 1) * 32 + (swz % 64) / 2; }
struct Unit { int pm, pn; };
struct Gemm { const bf16_t* A; const bf16_t* Bt; int M, N, K; };
struct StaticOrder {
    int nM, nN, nwg, G, c;
    __host__ __device__ void init(int M, int N, int G_, int c_) { nM = M / BM; nN = N / BM; nwg = nM * nN; G = G_; c = c_; }
    __host__ __device__ bool next(int i, Unit& u) const {
        const long L = (long)i * G + c; if (L >= nwg) return false;
        int wgid = (int)L; { const int q = nwg / NXCD, r = nwg % NXCD, xcd = wgid % NXCD, off = wgid / NXCD; wgid = (xcd < r ? xcd * (q + 1) : r * (q + 1) + (xcd - r) * q) + off; }
        const int nig = WGM * nN, gid = wgid / nig, fm = gid * WGM, gsz = (nM - fm) < WGM ? (nM - fm) : WGM;
        u.pm = fm + ((wgid % nig) % gsz); u.pn = (wgid % nig) / gsz; return true;
    }
};

template <class Epi>
__device__ __forceinline__ void gemm_phase(LAS unsigned char* lds, const Gemm g, const StaticOrder& S, const Epi& E) {
    int tid = threadIdx.x; asm volatile("" : "+v"(tid));
    const int wid = __builtin_amdgcn_readfirstlane(tid >> 6), lane = tid & 63, wr = wid >> 2, wc = wid & 3, fr = lane & 15, fq = lane >> 4;
    const int K = g.K, nt = K / BK;
    unsigned voffA[2];
#pragma unroll
    for (int i = 0; i < 2; ++i) { int R, C; stage_rc(tid * 16 + i * 8192, R, C); voffA[i] = (unsigned)(R * K + C) * 2u; }
    const size_t kstep = (size_t)(BK * 2);
    const size_t hstep = (size_t)HALF * K * 2;
    const size_t tstep = 2 * hstep;
    const unsigned ldsw = (unsigned)wid * 1024u;
    const int aoff = lds_byte(wr * 64 + fr, fq * 8), boff = lds_byte(wc * 32 + fr, fq * 8);
#define PG8_SA(b, h) (((b) * 2 + (h)) * HTB)
#define PG8_SB(b, h) ((4 + (b) * 2 + (h)) * HTB)
#define PG8_STAGE(bufoff, gbase) do { _Pragma("unroll") for (int _i = 0; _i < 2; ++_i) \
        __builtin_amdgcn_global_load_lds((const unsigned*)((const char*)(gbase) + voffA[_i]), (LAS unsigned*)(lds + (bufoff) + ldsw + _i * 8192), 16, 0, 0); } while (0)
#define PG8_LDA(dst, b, h) do { _Pragma("unroll") for (int m = 0; m < 4; ++m) _Pragma("unroll") for (int k = 0; k < 2; ++k) dst[m][k] = *(const LAS bf16x8*)(lds + PG8_SA(b, h) + aoff + m * 2048 + k * 1024); } while (0)
#define PG8_LDB(dst, b, h) do { _Pragma("unroll") for (int n = 0; n < 2; ++n) _Pragma("unroll") for (int k = 0; k < 2; ++k) dst[n][k] = *(const LAS bf16x8*)(lds + PG8_SB(b, h) + boff + n * 2048 + k * 1024); } while (0)
#define PG8_MMA(ai, bj, At, Bt) do { __builtin_amdgcn_s_setprio(1); _Pragma("unroll") for (int m = 0; m < 4; ++m) _Pragma("unroll") for (int n = 0; n < 2; ++n) _Pragma("unroll") for (int k = 0; k < 2; ++k) \
        acc[ai][bj][m][n] = __builtin_amdgcn_mfma_f32_16x16x32_bf16(Bt[n][k], At[m][k], acc[ai][bj][m][n], 0, 0, 0); __builtin_amdgcn_s_setprio(0); } while (0)
#define PG8_WAIT_V(n) asm volatile("s_waitcnt vmcnt(" #n ")" ::: "memory")
#define PG8_WAIT_L(n) asm volatile("s_waitcnt lgkmcnt(" #n ")" ::: "memory")
#define PG8_BAR __builtin_amdgcn_s_barrier()
#define PG8_SCHED __builtin_amdgcn_sched_barrier(0)
    Unit cur, nxt; int ui = 0;
    if (!S.next(0, cur)) return;
    f32x4 acc[2][2][4][2];
#pragma unroll
    for (int a = 0; a < 2; ++a)
#pragma unroll
        for (int b = 0; b < 2; ++b)
#pragma unroll
            for (int m = 0; m < 4; ++m)
#pragma unroll
                for (int n = 0; n < 2; ++n) acc[a][b][m][n] = (f32x4){0.f, 0.f, 0.f, 0.f};
    bf16x8 At[4][2], B0[2][2], B1[2][2];
    const char* cA = (const char*)g.A + (size_t)cur.pm * tstep; const char* cB = (const char*)g.Bt + (size_t)cur.pn * tstep;
    float pre[8];
    E.prefetch(cur, wr, fr, pre);
    PG8_STAGE(PG8_SB(0, 0), cB); PG8_STAGE(PG8_SB(0, 1), cB + hstep); PG8_STAGE(PG8_SA(0, 0), cA); PG8_STAGE(PG8_SA(0, 1), cA + hstep);
    if (wr == 1) PG8_BAR;
    PG8_WAIT_V(2); PG8_BAR;
    PG8_STAGE(PG8_SB(1, 0), cB + kstep); PG8_STAGE(PG8_SA(1, 0), cA + kstep); PG8_STAGE(PG8_SB(1, 1), cB + hstep + kstep);
    PG8_WAIT_V(6); PG8_BAR;
    for (;;) {
        const bool has_next = S.next(ui + 1, nxt);
        const char* nA = has_next ? (const char*)g.A + (size_t)nxt.pm * tstep : cA; const char* nB = has_next ? (const char*)g.Bt + (size_t)nxt.pn * tstep : cB;
        for (int t = 0; t < nt; t += 2) {
            const bool last = (t == nt - 2);
            const char* a1 = cA + (size_t)(t + 1) * kstep;
            const char* a2 = last ? nA : cA + (size_t)(t + 2) * kstep; const char* b2 = last ? nB : cB + (size_t)(t + 2) * kstep;
            const char* a3 = a2 + kstep; const char* b3 = b2 + kstep;
            PG8_LDB(B0, 0, 0); PG8_LDB(B1, 0, 1); PG8_SCHED; PG8_LDA(At, 0, 0); PG8_STAGE(PG8_SA(1, 1), a1 + hstep);
            PG8_WAIT_V(8); PG8_WAIT_L(0); PG8_BAR; PG8_MMA(0, 0, At, B0); PG8_MMA(0, 1, At, B1); PG8_BAR; PG8_SCHED;
            PG8_LDA(At, 0, 1); PG8_STAGE(PG8_SB(0, 0), b2); PG8_STAGE(PG8_SB(0, 1), b2 + hstep); PG8_STAGE(PG8_SA(0, 0), a2);
            PG8_WAIT_V(8); PG8_WAIT_L(0); PG8_BAR; PG8_MMA(1, 0, At, B0); PG8_MMA(1, 1, At, B1); PG8_BAR; PG8_SCHED;
            PG8_LDB(B0, 1, 0); PG8_LDB(B1, 1, 1); PG8_SCHED; PG8_LDA(At, 1, 0); PG8_STAGE(PG8_SA(0, 1), a2 + hstep);
            PG8_WAIT_V(8); PG8_WAIT_L(0); PG8_BAR; PG8_MMA(0, 0, At, B0); PG8_MMA(0, 1, At, B1); PG8_BAR; PG8_SCHED;
            PG8_LDA(At, 1, 1); PG8_STAGE(PG8_SB(1, 0), b3); PG8_STAGE(PG8_SB(1, 1), b3 + hstep); PG8_STAGE(PG8_SA(1, 0), a3);
            PG8_WAIT_V(8); PG8_WAIT_L(0); PG8_BAR; PG8_MMA(1, 0, At, B0); PG8_MMA(1, 1, At, B1); PG8_BAR; PG8_SCHED;
        }
        if (wr == 0) PG8_BAR;
        E(acc, cur, wr, wc, fr, fq, pre);
        if (has_next) E.prefetch(nxt, wr, fr, pre);
        if (!has_next) break;
#pragma unroll
        for (int a = 0; a < 2; ++a)
#pragma unroll
            for (int b = 0; b < 2; ++b)
#pragma unroll
                for (int m = 0; m < 4; ++m)
#pragma unroll
                    for (int n = 0; n < 2; ++n) acc[a][b][m][n] = (f32x4){0.f, 0.f, 0.f, 0.f};
        cur = nxt; cA = nA; cB = nB; ++ui;
        if (wr == 1) PG8_BAR;
    }
    PG8_WAIT_V(0);
    PG8_BAR;
#undef PG8_SA
#undef PG8_SB
#undef PG8_STAGE
#undef PG8_LDA
#undef PG8_LDB
#undef PG8_MMA
#undef PG8_WAIT_V
#undef PG8_WAIT_L
#undef PG8_BAR
#undef PG8_SCHED
}
template <class EpiMid, class EpiFin>
__device__ __forceinline__ void gemm_chain2(LAS unsigned char* lds, const Gemm g0, const Gemm g1, const StaticOrder& S, const EpiMid& Emid, const EpiFin& Efin) {
    int tid = threadIdx.x; asm volatile("" : "+v"(tid));
    const int wid = __builtin_amdgcn_readfirstlane(tid >> 6), lane = tid & 63, wr = wid >> 2, wc = wid & 3, fr = lane & 15, fq = lane >> 4;
    unsigned vo[2][2];
#pragma unroll
    for (int i = 0; i < 2; ++i) { int R, C; stage_rc(tid * 16 + i * 8192, R, C); vo[0][i] = (unsigned)(R * g0.K + C) * 2u; vo[1][i] = (unsigned)(R * g1.K + C) * 2u; }
    const size_t kstep = (size_t)(BK * 2);
    const size_t hs0 = (size_t)HALF * g0.K * 2, hs1 = (size_t)HALF * g1.K * 2;
    const unsigned ldsw = (unsigned)wid * 1024u;
    const int aoff = lds_byte(wr * 64 + fr, fq * 8), boff = lds_byte(wc * 32 + fr, fq * 8);
#define PG8_SA(b, h) (((b) * 2 + (h)) * HTB)
#define PG8_SB(b, h) ((4 + (b) * 2 + (h)) * HTB)
#define PG8_STAGE(bufoff, gbase, v0, v1) do { \
        __builtin_amdgcn_global_load_lds((const unsigned*)((const char*)(gbase) + (v0)), (LAS unsigned*)(lds + (bufoff) + ldsw), 16, 0, 0); \
        __builtin_amdgcn_global_load_lds((const unsigned*)((const char*)(gbase) + (v1)), (LAS unsigned*)(lds + (bufoff) + ldsw + 8192), 16, 0, 0); } while (0)
#define PG8_LDA(dst, b, h) do { _Pragma("unroll") for (int m = 0; m < 4; ++m) _Pragma("unroll") for (int k = 0; k < 2; ++k) dst[m][k] = *(const LAS bf16x8*)(lds + PG8_SA(b, h) + aoff + m * 2048 + k * 1024); } while (0)
#define PG8_LDB(dst, b, h) do { _Pragma("unroll") for (int n = 0; n < 2; ++n) _Pragma("unroll") for (int k = 0; k < 2; ++k) dst[n][k] = *(const LAS bf16x8*)(lds + PG8_SB(b, h) + boff + n * 2048 + k * 1024); } while (0)
#define PG8_MMA(ai, bj, At, Bt) do { __builtin_amdgcn_s_setprio(1); _Pragma("unroll") for (int m = 0; m < 4; ++m) _Pragma("unroll") for (int n = 0; n < 2; ++n) _Pragma("unroll") for (int k = 0; k < 2; ++k) \
        acc[ai][bj][m][n] = __builtin_amdgcn_mfma_f32_16x16x32_bf16(Bt[n][k], At[m][k], acc[ai][bj][m][n], 0, 0, 0); __builtin_amdgcn_s_setprio(0); } while (0)
#define PG8_WAIT_V(n) asm volatile("s_waitcnt vmcnt(" #n ")" ::: "memory")
#define PG8_WAIT_L(n) asm volatile("s_waitcnt lgkmcnt(" #n ")" ::: "memory")
#define PG8_BAR __builtin_amdgcn_s_barrier()
#define PG8_SCHED __builtin_amdgcn_sched_barrier(0)
    Unit cur, nxt; int ui = 0;
    if (!S.next(0, cur)) return;
    f32x4 acc[2][2][4][2];
#pragma unroll
    for (int a = 0; a < 2; ++a)
#pragma unroll
        for (int b = 0; b < 2; ++b)
#pragma unroll
            for (int m = 0; m < 4; ++m)
#pragma unroll
                for (int n = 0; n < 2; ++n) acc[a][b][m][n] = (f32x4){0.f, 0.f, 0.f, 0.f};
    bf16x8 At[4][2], B0[2][2], B1[2][2];
    int seg = 0;
    const char* cA = (const char*)g0.A + (size_t)cur.pm * 2 * hs0; const char* cB = (const char*)g0.Bt + (size_t)cur.pn * 2 * hs0;
    PG8_STAGE(PG8_SB(0, 0), cB, vo[0][0], vo[0][1]); PG8_STAGE(PG8_SB(0, 1), cB + hs0, vo[0][0], vo[0][1]); PG8_STAGE(PG8_SA(0, 0), cA, vo[0][0], vo[0][1]); PG8_STAGE(PG8_SA(0, 1), cA + hs0, vo[0][0], vo[0][1]);
    if (wr == 1) PG8_BAR;
    PG8_WAIT_V(2); PG8_BAR;
    PG8_STAGE(PG8_SB(1, 0), cB + kstep, vo[0][0], vo[0][1]); PG8_STAGE(PG8_SA(1, 0), cA + kstep, vo[0][0], vo[0][1]); PG8_STAGE(PG8_SB(1, 1), cB + hs0 + kstep, vo[0][0], vo[0][1]);
    PG8_WAIT_V(6); PG8_BAR;
    for (;;) {
        const bool has_next = S.next(ui + 1, nxt);
        const int nt = (seg ? g1.K : g0.K) / BK;
        const size_t hsc = seg ? hs1 : hs0;
        const unsigned c0 = seg ? vo[1][0] : vo[0][0], c1 = seg ? vo[1][1] : vo[0][1];
        const bool wrap = (seg == 1) && !has_next;
        const int nseg = wrap ? seg : (seg ^ 1);
        const size_t hsn = nseg ? hs1 : hs0;
        const unsigned n0 = nseg ? vo[1][0] : vo[0][0], n1 = nseg ? vo[1][1] : vo[0][1];
        const Unit& nu = (seg == 0) ? cur : nxt;
        const char* nA = wrap ? cA : (nseg ? (const char*)g1.A + (size_t)nu.pm * 2 * hs1 : (const char*)g0.A + (size_t)nu.pm * 2 * hs0);
        const char* nB = wrap ? cB : (nseg ? (const char*)g1.Bt + (size_t)nu.pn * 2 * hs1 : (const char*)g0.Bt + (size_t)nu.pn * 2 * hs0);
        for (int t = 0; t < nt; t += 2) {
            const bool last = (t == nt - 2);
            const char* a1 = cA + (size_t)(t + 1) * kstep;
            const char* a2 = last ? nA : cA + (size_t)(t + 2) * kstep; const char* b2 = last ? nB : cB + (size_t)(t + 2) * kstep;
            const char* a3 = a2 + kstep; const char* b3 = b2 + kstep;
            const size_t hs2 = last ? hsn : hsc; const unsigned x0 = last ? n0 : c0, x1 = last ? n1 : c1;
            PG8_LDB(B0, 0, 0); PG8_LDB(B1, 0, 1); PG8_SCHED; PG8_LDA(At, 0, 0); PG8_STAGE(PG8_SA(1, 1), a1 + hsc, c0, c1);
            PG8_WAIT_V(8); PG8_WAIT_L(0); PG8_BAR; PG8_MMA(0, 0, At, B0); PG8_MMA(0, 1, At, B1); PG8_BAR; PG8_SCHED;
            PG8_LDA(At, 0, 1); PG8_STAGE(PG8_SB(0, 0), b2, x0, x1); PG8_STAGE(PG8_SB(0, 1), b2 + hs2, x0, x1); PG8_STAGE(PG8_SA(0, 0), a2, x0, x1);
            PG8_WAIT_V(8); PG8_WAIT_L(0); PG8_BAR; PG8_MMA(1, 0, At, B0); PG8_MMA(1, 1, At, B1); PG8_BAR; PG8_SCHED;
            PG8_LDB(B0, 1, 0); PG8_LDB(B1, 1, 1); PG8_SCHED; PG8_LDA(At, 1, 0); PG8_STAGE(PG8_SA(0, 1), a2 + hs2, x0, x1);
            PG8_WAIT_V(8); PG8_WAIT_L(0); PG8_BAR; PG8_MMA(0, 0, At, B0); PG8_MMA(0, 1, At, B1); PG8_BAR; PG8_SCHED;
            PG8_LDA(At, 1, 1); PG8_STAGE(PG8_SB(1, 0), b3, x0, x1); PG8_STAGE(PG8_SB(1, 1), b3 + hs2, x0, x1); PG8_STAGE(PG8_SA(1, 0), a3, x0, x1);
            PG8_WAIT_V(8); PG8_WAIT_L(0); PG8_BAR; PG8_MMA(1, 0, At, B0); PG8_MMA(1, 1, At, B1); PG8_BAR; PG8_SCHED;
        }
        if (wr == 0) PG8_BAR;
        if (seg == 0) Emid(acc, cur, wr, wc, fr, fq); else Efin(acc, cur, wr, wc, fr, fq);
        if (wrap) break;
        if (seg == 1) {
#pragma unroll
            for (int a = 0; a < 2; ++a)
#pragma unroll
                for (int b = 0; b < 2; ++b)
#pragma unroll
                    for (int m = 0; m < 4; ++m)
#pragma unroll
                        for (int n = 0; n < 2; ++n) acc[a][b][m][n] = (f32x4){0.f, 0.f, 0.f, 0.f};
            cur = nxt; ++ui;
        }
        cA = nA; cB = nB; seg = nseg;
        if (wr == 1) PG8_BAR;
    }
    PG8_WAIT_V(0);
    PG8_BAR;
#undef PG8_SA
#undef PG8_SB
#undef PG8_STAGE
#undef PG8_LDA
#undef PG8_LDB
#undef PG8_MMA
#undef PG8_WAIT_V
#undef PG8_WAIT_L
#undef PG8_BAR
#undef PG8_SCHED
}
template <class Epi>
__device__ __forceinline__ void gemm_mhalf(LAS unsigned char* lds, const Gemm g, int G, int c, const Epi& E) {
    int tid = threadIdx.x; asm volatile("" : "+v"(tid));
    const int wid = __builtin_amdgcn_readfirstlane(tid >> 6), lane = tid & 63, wr = wid >> 2, wc = wid & 3, fr = lane & 15, fq = lane >> 4;
    const int K = g.K, nt = K / BK, nN = g.N / BM, nU = (g.M / HALF) * nN;
    unsigned voffA[2], voffG[2];
#pragma unroll
    for (int i = 0; i < 2; ++i) { int R, C; stage_rc(tid * 16 + i * 8192, R, C); voffA[i] = (unsigned)(R * K + C) * 2u; voffG[i] = (unsigned)(R * 32 + (C >> 4) * 65536 + (C & 15) * 2); }
    const size_t kstep = (size_t)(BK * 2), kstepA = (size_t)4 * 65536;
    const size_t hstep = (size_t)HALF * K * 2;
    const unsigned ldsw = (unsigned)wid * 1024u;
    const int aoff = lds_byte(wr * 64 + fr, fq * 8), boff = lds_byte(wc * 32 + fr, fq * 8);
#define PG8_SA(b, h) (((b) * 2 + (h)) * HTB)
#define PG8_SB(b, h) ((4 + (b) * 2 + (h)) * HTB)
#define PG8_STAGE(bufoff, gbase) do { _Pragma("unroll") for (int _i = 0; _i < 2; ++_i) \
        __builtin_amdgcn_global_load_lds((const unsigned*)((const char*)(gbase) + voffA[_i]), (LAS unsigned*)(lds + (bufoff) + ldsw + _i * 8192), 16, 0, 0); } while (0)
#define PG8_STAGE_A(bufoff, gbase) do { _Pragma("unroll") for (int _i = 0; _i < 2; ++_i) \
        __builtin_amdgcn_global_load_lds((const unsigned*)((const char*)(gbase) + voffG[_i]), (LAS unsigned*)(lds + (bufoff) + ldsw + _i * 8192), 16, 0, 0); } while (0)
#define PG8_LDA(dst, b, h) do { _Pragma("unroll") for (int m = 0; m < 4; ++m) _Pragma("unroll") for (int k = 0; k < 2; ++k) dst[m][k] = *(const LAS bf16x8*)(lds + PG8_SA(b, h) + aoff + m * 2048 + k * 1024); } while (0)
#define PG8_LDB(dst, b, h) do { _Pragma("unroll") for (int n = 0; n < 2; ++n) _Pragma("unroll") for (int k = 0; k < 2; ++k) dst[n][k] = *(const LAS bf16x8*)(lds + PG8_SB(b, h) + boff + n * 2048 + k * 1024); } while (0)
#define PG8_MMA(ai, bj, At, Bt) do { __builtin_amdgcn_s_setprio(1); _Pragma("unroll") for (int m = 0; m < 4; ++m) _Pragma("unroll") for (int n = 0; n < 2; ++n) _Pragma("unroll") for (int k = 0; k < 2; ++k) \
        acc[ai][bj][m][n] = __builtin_amdgcn_mfma_f32_16x16x32_bf16(Bt[n][k], At[m][k], acc[ai][bj][m][n], 0, 0, 0); __builtin_amdgcn_s_setprio(0); } while (0)
#define PG8_WAIT_V(n) asm volatile("s_waitcnt vmcnt(" #n ")" ::: "memory")
#define PG8_WAIT_L(n) asm volatile("s_waitcnt lgkmcnt(" #n ")" ::: "memory")
#define PG8_BAR __builtin_amdgcn_s_barrier()
#define PG8_SCHED __builtin_amdgcn_sched_barrier(0)
    int ui = 0;
    if (c >= nU) return;
    Unit cur{c / nN, c % nN}, nxt{0, 0};
    f32x4 acc[2][2][4][2];
#pragma unroll
    for (int a = 0; a < 2; ++a)
#pragma unroll
        for (int b = 0; b < 2; ++b)
#pragma unroll
            for (int m = 0; m < 4; ++m)
#pragma unroll
                for (int n = 0; n < 2; ++n) acc[a][b][m][n] = (f32x4){0.f, 0.f, 0.f, 0.f};
    bf16x8 At[4][2], B0[2][2], B1[2][2];
#define PG8_ABASE(u) ((const char*)g.A + ((size_t)(((u).pm * HALF) >> 11) * (K / 16) * 2048 + (((u).pm * HALF) & 2047)) * 32)
    const char* cA = PG8_ABASE(cur); const char* cB = (const char*)g.Bt + (size_t)cur.pn * 2 * hstep;
    PG8_STAGE(PG8_SB(0, 0), cB); PG8_STAGE(PG8_SB(0, 1), cB + hstep); PG8_STAGE_A(PG8_SA(0, 0), cA);
    if (wr == 1) PG8_BAR;
    PG8_WAIT_V(0); PG8_BAR;
    PG8_STAGE(PG8_SB(1, 0), cB + kstep); PG8_STAGE(PG8_SB(1, 1), cB + hstep + kstep); PG8_STAGE_A(PG8_SA(1, 0), cA + kstepA);
    PG8_BAR;
    for (;;) {
        const long Ln = (long)(ui + 1) * G + c; const bool has_next = Ln < nU;
        if (has_next) { nxt.pm = (int)(Ln / nN); nxt.pn = (int)(Ln % nN); }
        const char* nA = has_next ? PG8_ABASE(nxt) : cA; const char* nB = has_next ? (const char*)g.Bt + (size_t)nxt.pn * 2 * hstep : cB;
        for (int t = 0; t < nt; t += 2) {
            const bool last = (t == nt - 2);
            const char* a2 = last ? nA : cA + (size_t)(t + 2) * kstepA; const char* b2 = last ? nB : cB + (size_t)(t + 2) * kstep;
            const char* a3 = a2 + kstepA; const char* b3 = b2 + kstep;
            PG8_LDB(B0, 0, 0); PG8_LDB(B1, 0, 1); PG8_SCHED; PG8_LDA(At, 0, 0);
            PG8_WAIT_L(0); PG8_BAR; PG8_MMA(0, 0, At, B0); PG8_MMA(0, 1, At, B1); PG8_BAR; PG8_SCHED;
            PG8_STAGE(PG8_SB(0, 0), b2); PG8_STAGE(PG8_SB(0, 1), b2 + hstep); PG8_STAGE_A(PG8_SA(0, 0), a2);
            PG8_WAIT_V(6); PG8_BAR; PG8_BAR; PG8_SCHED;
            PG8_LDB(B0, 1, 0); PG8_LDB(B1, 1, 1); PG8_SCHED; PG8_LDA(At, 1, 0);
            PG8_WAIT_L(0); PG8_BAR; PG8_MMA(0, 0, At, B0); PG8_MMA(0, 1, At, B1); PG8_BAR; PG8_SCHED;
            PG8_STAGE(PG8_SB(1, 0), b3); PG8_STAGE(PG8_SB(1, 1), b3 + hstep); PG8_STAGE_A(PG8_SA(1, 0), a3);
            PG8_WAIT_V(6); PG8_BAR; PG8_BAR; PG8_SCHED;
        }
        if (wr == 0) PG8_BAR;
        E(acc, cur, wr, wc, fr, fq);
        if (!has_next) break;
#pragma unroll
        for (int b = 0; b < 2; ++b)
#pragma unroll
            for (int m = 0; m < 4; ++m)
#pragma unroll
                for (int n = 0; n < 2; ++n) acc[0][b][m][n] = (f32x4){0.f, 0.f, 0.f, 0.f};
        cur = nxt; cA = nA; cB = nB; ++ui;
        if (wr == 1) PG8_BAR;
    }
    PG8_WAIT_V(0);
    PG8_BAR;
#undef PG8_SA
#undef PG8_SB
#undef PG8_STAGE
#undef PG8_STAGE_A
#undef PG8_ABASE
#undef PG8_LDA
#undef PG8_LDB
#undef PG8_MMA
#undef PG8_WAIT_V
#undef PG8_WAIT_L
#undef PG8_BAR
#undef PG8_SCHED
}
}

#define XB_TMO      128
#define XB_XCNT(j)  (256  + 64 * (j))
#define XB_XSUB(j)  (1280 + 64 * (j))
#define XB_XGEN(j)  (2304 + 64 * (j))
#define XB_TOP      3328
#define XB_TOPGEN   3392
#define XCD_BAR_WORDS 3456
#define XB_SPIN_CAP (1u << 18)
__device__ __forceinline__ unsigned xb_ld(unsigned* p)              { return __hip_atomic_load(p, __ATOMIC_RELAXED, __HIP_MEMORY_SCOPE_AGENT); }
__device__ __forceinline__ unsigned xb_add(unsigned* p, unsigned v) { return __hip_atomic_fetch_add(p, v, __ATOMIC_RELAXED, __HIP_MEMORY_SCOPE_AGENT); }
__device__ __forceinline__ unsigned xb_xcc_id() { return (unsigned)__builtin_amdgcn_s_getreg((3 << 11) | 20) & 0xFu; }
#define XB_SPIN(cond, bar) do { unsigned _sp = 0; while (cond) { __builtin_amdgcn_s_sleep(1); \
    if ((++_sp & 255u) == 0u) { if (xb_ld(&(bar)[XB_TMO])) break; if (_sp > XB_SPIN_CAP) { atomicAdd(&(bar)[XB_TMO], 1u); break; } } } } while (0)
struct XcdBarrier { unsigned* bar; unsigned x; volatile LAS unsigned* st; };
__device__ __forceinline__ XcdBarrier xcd_barrier_post(unsigned* bar, volatile LAS unsigned* st) {
    XcdBarrier b; b.bar = bar; b.x = xb_xcc_id(); b.st = st;
    if (threadIdx.x == 0) (void)xb_add(&bar[XB_XCNT(b.x)], 1u);
    return b;
}
__device__ __forceinline__ void xcd_barrier_complete(unsigned* bar, unsigned x, unsigned& nloc, unsigned& nx) {
    const unsigned G = gridDim.x * gridDim.y * gridDim.z;
    unsigned sum, cnt, mine, sp = 0u;
    for (;;) {
        sum = 0u; cnt = 0u; mine = 0u;
#pragma unroll
        for (unsigned j = 0; j < 16; ++j) { const unsigned c = xb_ld(&bar[XB_XCNT(j)]); sum += c; cnt += (c > 0u) ? 1u : 0u; mine = (j == x) ? c : mine; }
        if (sum == G) break;
        __builtin_amdgcn_s_sleep(1);
        if ((++sp & 255u) == 0u) { if (xb_ld(&bar[XB_TMO])) break; if (sp > XB_SPIN_CAP) { atomicAdd(&bar[XB_TMO], 1u); break; } }
    }
    nloc = mine > 0u ? mine : 1u; nx = cnt > 0u ? cnt : 1u;
}
__device__ __forceinline__ void xcd_barrier(const XcdBarrier& b) {
    asm volatile("s_waitcnt vmcnt(0)" ::: "memory");
    __syncthreads();
    if (threadIdx.x == 0) {
        unsigned* bar = b.bar;
        __builtin_amdgcn_s_waitcnt(0);
        unsigned nloc = b.st[0], nx = b.st[1];
        if (nloc == 0u) { xcd_barrier_complete(bar, b.x, nloc, nx); b.st[0] = nloc; b.st[1] = nx; }
        const unsigned old = xb_add(&bar[XB_XSUB(b.x)], 1u);
        const unsigned gen = old / nloc;
        if (old + 1u == (gen + 1u) * nloc) {
            __builtin_amdgcn_fence(__ATOMIC_RELEASE, "agent");
            asm volatile("s_waitcnt vmcnt(0)" ::: "memory");
            const unsigned og = xb_add(&bar[XB_TOP], 1u);
            const unsigned tg = og / nx;
            if (og + 1u == (tg + 1u) * nx) xb_add(&bar[XB_TOPGEN], 1u);
            else XB_SPIN(xb_ld(&bar[XB_TOPGEN]) == tg, bar);
            __builtin_amdgcn_fence(__ATOMIC_ACQUIRE, "agent");
            xb_add(&bar[XB_XGEN(b.x)], 1u);
            asm volatile("s_waitcnt vmcnt(0)" ::: "memory");
        } else {
            XB_SPIN(xb_ld(&bar[XB_XGEN(b.x)]) == gen, bar);
            __builtin_amdgcn_fence(__ATOMIC_ACQUIRE, "agent");
            asm volatile("s_waitcnt vmcnt(0)" ::: "memory");
        }
    }
    __syncthreads();
}

typedef f32x4 (&AccRef)[2][2][4][2];
struct EpiIn {
    static constexpr bool IS_IN = true;
    const float* ss; const float* cw; bf16_t* ain; float* hcv; float* hg; bf16_t* u; bf16_t* szb; unsigned char* sga; unsigned char* sgb;
    __device__ __forceinline__ void prefetch(const pg8::Unit& un, int wr, int fr, float (&pre)[8]) const {
#pragma unroll
        for (int i = 0; i < 8; ++i) pre[i] = ss[un.pm * 256 + wr * 64 + fr + (i >> 2) * 128 + (i & 3) * 16];
    }
    __device__ __forceinline__ void operator()(AccRef acc, const pg8::Unit& un, int wr, int wc, int fr, int fq, const float (&pre)[8]) const {
        const int row0 = un.pm * 256 + wr * 64 + fr;
        if (un.pn < 32) {
            const int c0 = un.pn * 64 + wc * 16 + fq * 4;
            const f32x4 w0 = *(const f32x4*)(cw + c0), w1 = *(const f32x4*)(cw + CW + c0), w2 = *(const f32x4*)(cw + 2 * CW + c0);
#pragma unroll
            for (int ai = 0; ai < 2; ++ai) {
                f32x4 cvv[4], gt[4];
#pragma unroll
                for (int m = 0; m < 4; ++m) {
                    const float rs = rsqrtf(pre[ai * 4 + m] * (1.0f / DM) + RMS_EPS);
                    const f32x4 v = acc[ai][0][m][0] * rs, bg = acc[ai][0][m][1] * rs, cgv = acc[ai][1][m][0] * rs, za = acc[ai][1][m][1] * rs;
                    cvv[m] = cgv * v; gt[m] = bg * silu4(za);
                }
                const int blk = un.pm * 4 + ai * 2 + wr;
#pragma unroll
                for (int m = 0; m < 4; ++m) {
                    const f32x4 s1 = dpp4<0x111>(cvv[m]), s2 = dpp4<0x112>(cvv[m]);
                    f32x4 p1 = s1, p2 = s2;
                    if (m > 0) { const f32x4 t1 = dpp4<0x10F>(cvv[m - 1]), t2 = dpp4<0x10E>(cvv[m - 1]);
                        if (fr < 1) p1 = t1; if (fr < 2) p2 = t2; }
                    const f32x4 o = gt[m] * (w0 * p2 + w1 * p1 + w2 * cvv[m]);
                    const size_t row = (size_t)(row0 + ai * 128 + m * 16);
                    if (m == 0) {
                        if (fr < 2) { *(f32x4*)(hg + ((size_t)blk * 2 + fr) * CW + c0) = gt[0]; *(f32x4*)(hcv + ((size_t)blk * 4 + 2 + fr) * CW + c0) = cvv[0]; }
                        else st_bf16x4(ain + row * CW + c0, o);
                    } else {
                        st_bf16x4(ain + row * CW + c0, o);
                        if (m == 3 && fr >= 14) *(f32x4*)(hcv + ((size_t)blk * 4 + (fr - 14)) * CW + c0) = cvv[3];
                    }
                }
            }
            return;
        }
#pragma unroll
        for (int ai = 0; ai < 2; ++ai)
#pragma unroll
            for (int m = 0; m < 4; ++m) {
                const int row = row0 + ai * 128 + m * 16;
                const float rs = rsqrtf(pre[ai * 4 + m] * (1.0f / DM) + RMS_EPS);
                if (un.pn < 40) {
#pragma unroll
                    for (int bj = 0; bj < 2; ++bj) {
                        const f32x4 v0 = acc[ai][bj][m][0] * rs, v1 = acc[ai][bj][m][1] * rs;
                        if (un.pn < 36) { const int cc = (un.pn - 32) * 256 + bj * 128 + wc * 32 + fq * 8;
                            st_bf16x8(u + ((size_t)((row >> 11) * SG + (cc >> 4)) * SEQ + (row & (SEQ - 1))) * SGC + (cc & 15), v0, v1); }
                        else st_bf16x8(szb + (size_t)row * SW + ((un.pn - 36) * 256 + bj * 128 + wc * 32 + fq * 8), silu4(v0), silu4(v1));
                    }
                }
                if (un.pn >= 40) {
                    unsigned char* gdst = (un.pn < 48 ? sga : sgb) + (size_t)row * DM + ((un.pn - (un.pn < 48 ? 40 : 48)) * 256 + wc * 32 + fq * 8);
#pragma unroll
                    for (int bj = 0; bj < 2; ++bj) { const f32x4 g0 = sig4(acc[ai][bj][m][0] * rs), g1 = sig4(acc[ai][bj][m][1] * rs); u32x2 w;
                        w.x = (unsigned)(g0.x * 255.f + 0.5f) | ((unsigned)(g0.y * 255.f + 0.5f) << 8) | ((unsigned)(g0.z * 255.f + 0.5f) << 16) | ((unsigned)(g0.w * 255.f + 0.5f) << 24);
                        w.y = (unsigned)(g1.x * 255.f + 0.5f) | ((unsigned)(g1.y * 255.f + 0.5f) << 8) | ((unsigned)(g1.z * 255.f + 0.5f) << 16) | ((unsigned)(g1.w * 255.f + 0.5f) << 24);
                        *(u32x2*)(gdst + bj * 128) = w; }
                }
            }
    }
};
struct EpiA {
    const bf16_t* sga; bf16_t* ma;
    __device__ __forceinline__ void prefetch(const pg8::Unit&, int, int, float (&)[8]) const {}
    __device__ __forceinline__ void operator()(AccRef acc, const pg8::Unit& un, int wr, int wc, int fr, int fq, const float (&)[8]) const { (*this)(acc, un, wr, wc, fr, fq); }
    __device__ __forceinline__ void operator()(AccRef acc, const pg8::Unit& un, int wr, int wc, int fr, int fq) const {
        const int row0 = un.pm * 256 + wr * 64 + fr, col0 = un.pn * 256 + wc * 32 + fq * 4;
#pragma unroll
        for (int ai = 0; ai < 2; ++ai)
#pragma unroll
            for (int m = 0; m < 4; ++m) {
                const size_t ro = (size_t)(row0 + ai * 128 + m * 16) * DM + col0;
#pragma unroll
                for (int bj = 0; bj < 2; ++bj)
#pragma unroll
                    for (int n = 0; n < 2; ++n) { const size_t o = ro + bj * 128 + n * 16; st_bf16x4(ma + o, acc[ai][bj][m][n] * ld_bf16x4(sga + o)); }
            }
    }
};
struct EpiMidAB {
    static constexpr bool IS_IN = false;
    const unsigned char* sga; const unsigned char* sgb;
    __device__ __forceinline__ void operator()(AccRef acc, const pg8::Unit& un, int wr, int wc, int fr, int fq) const {
        const int row0 = un.pm * 256 + wr * 64 + fr, col8 = un.pn * 256 + wc * 32 + fq * 8;
#pragma unroll
        for (int ai = 0; ai < 2; ++ai)
#pragma unroll
            for (int m = 0; m < 4; ++m) {
                const size_t ro = (size_t)(row0 + ai * 128 + m * 16) * DM + col8;
#pragma unroll
                for (int bj = 0; bj < 2; ++bj) { const u32x2 wa2 = *(const u32x2*)(sga + ro + bj * 128), wb2 = *(const u32x2*)(sgb + ro + bj * 128);
#pragma unroll
                    for (int n = 0; n < 2; ++n) { const unsigned wa = n ? wa2.y : wa2.x, wb = n ? wb2.y : wb2.x; f32x4 r;
                        r.x = (float)(wa & 255u) * __builtin_amdgcn_rcpf(fmaxf((float)(wb & 255u), 0.25f)); r.y = (float)((wa >> 8) & 255u) * __builtin_amdgcn_rcpf(fmaxf((float)((wb >> 8) & 255u), 0.25f));
                        r.z = (float)((wa >> 16) & 255u) * __builtin_amdgcn_rcpf(fmaxf((float)((wb >> 16) & 255u), 0.25f)); r.w = (float)(wa >> 24) * __builtin_amdgcn_rcpf(fmaxf((float)(wb >> 24), 0.25f));
                        acc[ai][bj][m][n] = acc[ai][bj][m][n] * r; } }
            }
    }
};
struct EpiFinAB {
    static constexpr bool IS_IN = false;
    const unsigned char* sgb; bf16_t* mo;
    __device__ __forceinline__ void operator()(AccRef acc, const pg8::Unit& un, int wr, int wc, int fr, int fq) const {
        const int row0 = un.pm * 256 + wr * 64 + fr, col8 = un.pn * 256 + wc * 32 + fq * 8;
        const float k = 1.0f / 255.0f;
#pragma unroll
        for (int ai = 0; ai < 2; ++ai)
#pragma unroll
            for (int m = 0; m < 4; ++m) {
                const size_t ro = (size_t)(row0 + ai * 128 + m * 16) * DM + col8;
#pragma unroll
                for (int bj = 0; bj < 2; ++bj) { const u32x2 wb2 = *(const u32x2*)(sgb + ro + bj * 128); f32x4 g[2];
#pragma unroll
                    for (int n = 0; n < 2; ++n) { const unsigned wb = n ? wb2.y : wb2.x;
                        g[n].x = fmaxf((float)(wb & 255u), 0.25f) * k; g[n].y = fmaxf((float)((wb >> 8) & 255u), 0.25f) * k; g[n].z = fmaxf((float)((wb >> 16) & 255u), 0.25f) * k; g[n].w = fmaxf((float)(wb >> 24), 0.25f) * k; }
                    st_bf16x8(mo + ro + bj * 128, acc[ai][bj][m][0] * g[0], acc[ai][bj][m][1] * g[1]); }
            }
    }
};
template <int NAI> struct EpiGluT {
    static constexpr bool IS_IN = false;
    const bf16_t* gi; const bf16_t* szb; const float* bglu; bf16_t* bin;
    __device__ __forceinline__ void prefetch(const pg8::Unit&, int, int, float (&)[8]) const {}
    __device__ __forceinline__ void operator()(AccRef acc, const pg8::Unit& un, int wr, int wc, int fr, int fq, const float (&)[8]) const { (*this)(acc, un, wr, wc, fr, fq); }
    __device__ __forceinline__ void operator()(AccRef acc, const pg8::Unit& un, int wr, int wc, int fr, int fq) const {
        const int row0 = un.pm * (128 * NAI) + wr * 64 + fr, col8 = un.pn * 256 + wc * 32 + fq * 8;
        f32x4 bv[2][2];
#pragma unroll
        for (int bj = 0; bj < 2; ++bj)
#pragma unroll
            for (int n = 0; n < 2; ++n) bv[bj][n] = *(const f32x4*)(bglu + col8 + bj * 128 + n * 4);
#pragma unroll
        for (int ai = 0; ai < NAI; ++ai)
#pragma unroll
            for (int m = 0; m < 4; ++m) {
                const int row = row0 + ai * 128 + m * 16;
#pragma unroll
                for (int bj = 0; bj < 2; ++bj) { const int col = col8 + bj * 128; const size_t o = (size_t)row * SW + col;
                    const size_t og = ((size_t)((row >> 11) * SG + (col >> 4)) * SEQ + (row & (SEQ - 1))) * SGC + (col & 15);
                    const F8 gv = ld_bf16x8(gi + og), zv = ld_bf16x8(szb + o);
                    st_bf16x8(bin + o, gv.lo * sig4(acc[ai][bj][m][0] + bv[bj][0]) * zv.lo, gv.hi * sig4(acc[ai][bj][m][1] + bv[bj][1]) * zv.hi); }
            }
    }
};
typedef EpiGluT<2> EpiGlu;
struct EpiB {
    const bf16_t* ma; const bf16_t* sgb; bf16_t* mo;
    __device__ __forceinline__ void prefetch(const pg8::Unit&, int, int, float (&)[8]) const {}
    __device__ __forceinline__ void operator()(AccRef acc, const pg8::Unit& un, int wr, int wc, int fr, int fq, const float (&)[8]) const { (*this)(acc, un, wr, wc, fr, fq); }
    __device__ __forceinline__ void operator()(AccRef acc, const pg8::Unit& un, int wr, int wc, int fr, int fq) const {
        const int row0 = un.pm * 256 + wr * 64 + fr, col0 = un.pn * 256 + wc * 32 + fq * 4;
#pragma unroll
        for (int ai = 0; ai < 2; ++ai)
#pragma unroll
            for (int m = 0; m < 4; ++m) {
                const size_t ro = (size_t)(row0 + ai * 128 + m * 16) * DM + col0;
#pragma unroll
                for (int bj = 0; bj < 2; ++bj)
#pragma unroll
                    for (int n = 0; n < 2; ++n) { const size_t o = ro + bj * 128 + n * 16; st_bf16x4(mo + o, ld_bf16x4(ma + o) + acc[ai][bj][m][n] * ld_bf16x4(sgb + o)); }
            }
    }
};
struct EpiO {
    const float* xin; float* xo; bf16_t* xb; float* ssn; bf16_t* xlo;
    __device__ __forceinline__ void prefetch(const pg8::Unit&, int, int, float (&)[8]) const {}
    __device__ __forceinline__ void operator()(AccRef acc, const pg8::Unit& un, int wr, int wc, int fr, int fq, const float (&)[8]) const { (*this)(acc, un, wr, wc, fr, fq); }
    __device__ __forceinline__ void operator()(AccRef acc, const pg8::Unit& un, int wr, int wc, int fr, int fq) const {
        const int row0 = un.pm * 256 + wr * 64 + fr, col8 = un.pn * 256 + wc * 32 + fq * 8;
#pragma unroll
        for (int ai = 0; ai < 2; ++ai)
#pragma unroll
            for (int m = 0; m < 4; ++m) {
                const int row = row0 + ai * 128 + m * 16;
                const size_t ro = (size_t)row * DM + col8; float s = 0.f;
#pragma unroll
                for (int bj = 0; bj < 2; ++bj) { const size_t o = ro + bj * 128;
                    const f32x4 v0 = *(const f32x4*)(xin + o) + acc[ai][bj][m][0], v1 = *(const f32x4*)(xin + o + 4) + acc[ai][bj][m][1];
                    if (xlo) st_bf16x8(xb + o, v0, v1);
                    else { *(f32x4*)(xo + o) = v0; *(f32x4*)(xo + o + 4) = v1; if (xb) st_bf16x8(xb + o, v0, v1); }
                    s += ((v0.x * v0.x + v0.y * v0.y) + (v0.z * v0.z + v0.w * v0.w)) + ((v1.x * v1.x + v1.y * v1.y) + (v1.z * v1.z + v1.w * v1.w)); }
                s += __shfl_xor(s, 16); s += __shfl_xor(s, 32);
                if (fq == 0 && ssn) atomicAdd(ssn + row, s);
            }
    }
};

struct EpiOFin {
    static constexpr bool IS_IN = false;
    const float* xin; float* out; float* ssn; const float* fg; XcdBarrier xb; const bf16_t* xhi; const bf16_t* xlo;
    __device__ __forceinline__ void prefetch(const pg8::Unit&, int, int, float (&)[8]) const {}
    __device__ __forceinline__ void operator()(AccRef acc, const pg8::Unit& un, int wr, int wc, int fr, int fq, const float (&)[8]) const { (*this)(acc, un, wr, wc, fr, fq); }
    __device__ __forceinline__ void operator()(AccRef acc, const pg8::Unit& un, int wr, int wc, int fr, int fq) const {
        const int row0 = un.pm * 256 + wr * 64 + fr, col8 = un.pn * 256 + wc * 32 + fq * 8;
#pragma unroll
        for (int ai = 0; ai < 2; ++ai)
#pragma unroll
            for (int m = 0; m < 4; ++m) {
                const int row = row0 + ai * 128 + m * 16;
                const size_t ro = (size_t)row * DM + col8; float s = 0.f;
#pragma unroll
                for (int bj = 0; bj < 2; ++bj) { const size_t o = ro + bj * 128; f32x4 x0, x1;
                    if (xhi) { const F8 h = ld_bf16x8(xhi + o); x0 = h.lo; x1 = h.hi; } else { x0 = *(const f32x4*)(xin + o); x1 = *(const f32x4*)(xin + o + 4); }
                    const f32x4 v0 = x0 + acc[ai][bj][m][0], v1 = x1 + acc[ai][bj][m][1]; acc[ai][bj][m][0] = v0; acc[ai][bj][m][1] = v1;
                    s += ((v0.x * v0.x + v0.y * v0.y) + (v0.z * v0.z + v0.w * v0.w)) + ((v1.x * v1.x + v1.y * v1.y) + (v1.z * v1.z + v1.w * v1.w)); }
                s += __shfl_xor(s, 16); s += __shfl_xor(s, 32);
                if (fq == 0) atomicAdd(ssn + row, s);
            }
        f32x4 gv[2][2];
#pragma unroll
        for (int bj = 0; bj < 2; ++bj)
#pragma unroll
            for (int n = 0; n < 2; ++n) gv[bj][n] = *(const f32x4*)(fg + col8 + bj * 128 + n * 4);
        xcd_barrier(xb);
#pragma unroll
        for (int ai = 0; ai < 2; ++ai)
#pragma unroll
            for (int m = 0; m < 4; ++m) {
                const int row = row0 + ai * 128 + m * 16;
                const float rs = rsqrtf(__hip_atomic_load(ssn + row, __ATOMIC_RELAXED, __HIP_MEMORY_SCOPE_AGENT) * (1.0f / DM) + RMS_EPS);
                const size_t ro = (size_t)row * DM + col8;
#pragma unroll
                for (int bj = 0; bj < 2; ++bj)
#pragma unroll
                    for (int n = 0; n < 2; ++n) *(f32x4*)(out + ro + bj * 128 + n * 4) = acc[ai][bj][m][n] * rs * gv[bj][n];
            }
    }
};

struct Args { const float* in[18]; float* out; unsigned char* ws; int lo, hi, coop, pad; };

__device__ __forceinline__ int perm_col(int np) { const int tc = np & 31; return (np & ~31) | (((tc >> 2) & 3) << 3) | (((tc >> 4) & 1) << 2) | (tc & 3); }
__device__ __forceinline__ int win_src_col(int np) {
    if (np >= 8192) return perm_col(np);
    const int tile = np >> 8, tc = np & 255, bj = tc >> 7, wc = (tc >> 5) & 3, n = (tc >> 4) & 1, lo = tc & 15;
    return (2 * bj + n) * 2048 + 64 * tile + 16 * wc + lo;
}
struct TrItem { const float* W; bf16_t* WT; const float* ksc; int K, N, k0, n0, perm; };
__device__ __forceinline__ TrItem tr_decode(const Args& a, int it) {
    constexpr int I_IN = (DM / 64) * (NIN / 32), I_A = (CW / 64) * (DM / 32), I_G = (SW / 64) * (SW / 32), I_B = (SW / 64) * (DM / 32), I_O = (DM / 64) * (DM / 32);
    constexpr int I_L = I_IN + I_A + I_G + I_B + I_O;
    unsigned char* ws = a.ws; TrItem t; const int l = it / I_L; int r = it % I_L; t.ksc = nullptr; t.perm = 0;
    if (r < I_IN) { t.W = a.in[2] + (size_t)l * DM * NIN; t.WT = (bf16_t*)(ws + WS_WIN) + (size_t)l * NIN * DM; t.K = DM; t.N = NIN; t.ksc = a.in[1] + l * DM; t.perm = 1; }
    else if ((r -= I_IN) < I_A) { t.W = a.in[4] + (size_t)l * CW * DM; t.WT = (bf16_t*)(ws + WS_WA) + (size_t)l * DM * CW; t.K = CW; t.N = DM; }
    else if ((r -= I_A) < I_G) { t.W = a.in[13] + (size_t)l * SW * SW; t.WT = (bf16_t*)(ws + WS_WGLU) + (size_t)l * SW * SW; t.K = SW; t.N = SW; }
    else if ((r -= I_G) < I_B) { t.W = a.in[15] + (size_t)l * SW * DM; t.WT = (bf16_t*)(ws + WS_WB) + (size_t)l * DM * SW; t.K = SW; t.N = DM; }
    else { r -= I_B; t.W = a.in[16] + (size_t)l * DM * DM; t.WT = (bf16_t*)(ws + WS_WO) + (size_t)l * DM * DM; t.K = DM; t.N = DM; }
    const int nblk = t.N / 32; t.k0 = 64 * (r / nblk); t.n0 = 32 * (r % nblk);
    return t;
}
__device__ __forceinline__ void tr_load(const TrItem& t, int lane, f32x4 (&v)[8]) {
    const int kq = lane >> 3, np = t.n0 + 4 * (lane & 7), sc = t.perm ? win_src_col(np) : perm_col(np);
    const float* p = t.W + (size_t)(t.k0 + kq) * t.N + sc;
#pragma unroll
    for (int i = 0; i < 8; ++i) v[i] = *(const f32x4*)(p + (size_t)(8 * i) * t.N);
}
__device__ __forceinline__ void tr_store(const TrItem& t, int lane, f32x4 (&v)[8], LAS float* scr) {
    const int kq = lane >> 3, n4 = lane & 7;
#pragma unroll
    for (int i = 0; i < 8; ++i) { const int kk = 8 * i + kq; const float sc = t.ksc ? t.ksc[t.k0 + kk] : 1.0f; LAS float* d = scr + kk * 33 + 4 * n4;
        d[0] = v[i].x * sc; d[1] = v[i].y * sc; d[2] = v[i].z * sc; d[3] = v[i].w * sc; }
    LDS_WAIT();
    const int c = lane & 7;
#pragma unroll
    for (int j = 0; j < 4; ++j) { const int n = (lane >> 3) + 8 * j; const LAS float* s = scr + (8 * c) * 33 + n;
        u32x4 o; o.x = cvt_pk_bf16(s[0 * 33], s[1 * 33]); o.y = cvt_pk_bf16(s[2 * 33], s[3 * 33]); o.z = cvt_pk_bf16(s[4 * 33], s[5 * 33]); o.w = cvt_pk_bf16(s[6 * 33], s[7 * 33]);
        *(u32x4*)(t.WT + (size_t)(t.n0 + n) * t.K + t.k0 + 8 * c) = o; }
    LDS_WAIT();
}

__device__ __forceinline__ void ssm_coef(const Args& a, int idx, float& lre, float& lim, float& cre, float& cim) {
    const float are = a.in[5][idx], aim = a.in[6][idx], dt = expf(a.in[7][idx / SP]);
    const float e = expf(are * dt); float sn, cs; sincosf(aim * dt, &sn, &cs);
    lre = e * cs; lim = e * sn;
    const float nre = lre - 1.f, nim = lim, den = 1.0f / (are * are + aim * aim);
    cre = (nre * are + nim * aim) * den; cim = (nim * are - nre * aim) * den;
}
__device__ __forceinline__ void phase_prologue(const Args& a, LAS unsigned char* lds, int gw, int NGW, int wave, int lane) {
    unsigned char* ws = a.ws;
    LAS float* scr = (LAS float*)(lds + wave * 16384);
    constexpr int I_TOT = DEPTH * ((DM / 64) * (NIN / 32) + (CW / 64) * (DM / 32) + (SW / 64) * (SW / 32) + (SW / 64) * (DM / 32) + (DM / 64) * (DM / 32));
    {
        TrItem ta = tr_decode(a, gw), tb = ta; f32x4 va[8], vb[8];
        bool hb = (gw + NGW) < I_TOT;
        tr_load(ta, lane, va);
        if (hb) { tb = tr_decode(a, gw + NGW); tr_load(tb, lane, vb); }
        for (int it = gw; it < I_TOT; it += 2 * NGW) {
            const int nit = it + 2 * NGW; const bool na = nit < I_TOT, nb = (nit + NGW) < I_TOT;
            TrItem tc = ta, td = tb; f32x4 vc[8], vd[8];
#pragma unroll
            for (int i = 0; i < 8; ++i) { vc[i] = (f32x4){0.f, 0.f, 0.f, 0.f}; vd[i] = vc[i]; }
            if (na) { tc = tr_decode(a, nit); tr_load(tc, lane, vc); }
            if (nb) { td = tr_decode(a, nit + NGW); tr_load(td, lane, vd); }
            tr_store(ta, lane, va, scr); if (hb) tr_store(tb, lane, vb, scr);
            ta = tc; tb = td; hb = nb;
#pragma unroll
            for (int i = 0; i < 8; ++i) { va[i] = vc[i]; vb[i] = vd[i]; }
        }
    }
    float* ss = (float*)(ws + WS_SS);
    for (int row = gw; row < MTOK; row += NGW) {
        const f32x4* xr = (const f32x4*)(a.in[0] + (size_t)row * DM) + lane; float s = 0.f;
        u32x2* o = (u32x2*)((bf16_t*)(ws + WS_XB) + (size_t)row * DM) + lane;
#pragma unroll
        for (int j = 0; j < 8; ++j) { const f32x4 v = xr[64 * j]; s += (v.x * v.x + v.y * v.y) + (v.z * v.z + v.w * v.w); u32x2 w; w.x = cvt_pk_bf16(v.x, v.y); w.y = cvt_pk_bf16(v.z, v.w); o[64 * j] = w; }
        s = wave_sum(s);
        if (lane == 0) { ss[row] = s; ss[MTOK + row] = 0.f; ss[2 * MTOK + row] = 0.f; }
    }
    const int gt = gw * 64 + lane;
    if (gt < DEPTH * SG * SP) {
        float lre, lim, cre, cim; ssm_coef(a, gt, lre, lim, cre, cim);
        ((f32x2*)(ws + WS_LAMB))[gt] = (f32x2){lre, lim};
        float tre = lre, tim = lim;
#pragma unroll
        for (int k = 0; k < 8; ++k) { const float nr = tre * tre - tim * tim, ni = 2.f * tre * tim; tre = nr; tim = ni; }
        ((f32x2*)(ws + WS_LAMT))[gt] = (f32x2){tre, tim};
    }
    if (gt < DEPTH * SG * 8 * 64) {
        const int ln = gt & 63, nt = (gt >> 6) & 7, lg = gt >> 9, fr = ln & 15, fq = ln >> 4, p = 8 * nt + (fr >> 1), ri = fr & 1;
        float lre, lim, cre, cim; ssm_coef(a, lg * SP + p, lre, lim, cre, cim);
        float v[8];
#pragma unroll
        for (int j = 0; j < 8; ++j) { const int c = (8 * fq + j) & 15; const float br = a.in[8][((size_t)lg * SP + p) * SGC + c], bi = a.in[9][((size_t)lg * SP + p) * SGC + c];
            v[j] = ri ? (cre * bi + cim * br) : (cre * br - cim * bi); }
        u32x4 o; o.x = cvt_pk_bf16(v[0], v[1]); o.y = cvt_pk_bf16(v[2], v[3]); o.z = cvt_pk_bf16(v[4], v[5]); o.w = cvt_pk_bf16(v[6], v[7]);
        ((u32x4*)(ws + WS_BF))[gt] = o;
    }
    if (gt < DEPTH * SG * 4 * 64) {
        const int ln = gt & 63, kk = (gt >> 6) & 3, lg = gt >> 8, fr = ln & 15, fq = ln >> 4;
        float v[8];
#pragma unroll
        for (int j = 0; j < 8; ++j) { const int p = 16 * kk + 4 * fq + (j >> 1); const size_t ci = ((size_t)lg * SGC + fr) * SP + p; v[j] = (j & 1) ? -a.in[11][ci] : a.in[10][ci]; }
        u32x4 o; o.x = cvt_pk_bf16(v[0], v[1]); o.y = cvt_pk_bf16(v[2], v[3]); o.z = cvt_pk_bf16(v[4], v[5]); o.w = cvt_pk_bf16(v[6], v[7]);
        ((u32x4*)(ws + WS_CF))[gt] = o;
    }
}

__device__ __forceinline__ void phase_convfix(const Args& a, int l, int gtid, int ngt) {
    unsigned char* ws = a.ws;
    const float* hcv = (const float*)(ws + WS_CV); const float* hg = (const float*)(ws + WS_GATE); bf16_t* ain = (bf16_t*)(ws + WS_AIN);
    const float* cw = a.in[3] + (size_t)l * 3 * CW;
    for (int idx = gtid; idx < (MTOK / 64) * 2 * (CW / 4); idx += ngt) {
        const int c4 = (idx & (CW / 4 - 1)) * 4, rr = (idx / (CW / 4)) & 1, blk = idx / (2 * (CW / 4));
        const int row = blk * 64 + rr, t = row & (SEQ - 1);
        const f32x4 z = (f32x4){0.f, 0.f, 0.f, 0.f};
        const f32x4 x0 = *(const f32x4*)(hcv + ((size_t)blk * 4 + 2 + rr) * CW + c4);
        f32x4 x1, x2;
        if (rr == 1) { x1 = *(const f32x4*)(hcv + ((size_t)blk * 4 + 2) * CW + c4); x2 = (t >= 2) ? *(const f32x4*)(hcv + ((size_t)(blk - 1) * 4 + 1) * CW + c4) : z; }
        else { x1 = (t >= 1) ? *(const f32x4*)(hcv + ((size_t)(blk - 1) * 4 + 1) * CW + c4) : z; x2 = (t >= 2) ? *(const f32x4*)(hcv + ((size_t)(blk - 1) * 4 + 0) * CW + c4) : z; }
        const f32x4 g = *(const f32x4*)(hg + ((size_t)blk * 2 + rr) * CW + c4);
        const f32x4 w0 = *(const f32x4*)(cw + c4), w1 = *(const f32x4*)(cw + CW + c4), w2 = *(const f32x4*)(cw + 2 * CW + c4);
        st_bf16x4(ain + (size_t)row * CW + c4, g * (w0 * x2 + w1 * x1 + w2 * x0));
    }
}

constexpr int SC_BU_ROW = 528, SC_HB_ROW = 272, SC_WAVE_BYTES = 16 * SC_BU_ROW + 16 * SC_HB_ROW;
template <int PASS, bool LDSX>
__device__ __forceinline__ void phase_scan(const Args& a, int l, LAS unsigned char* lds, int gw, int NGW, int wave, int lane) {
    unsigned char* ws = a.ws;
    const bf16_t* ubase = (const bf16_t*)(ws + WS_U) + (size_t)l * MTOK * SW;
    f32x2* st = (f32x2*)(ws + WS_ST);
    LAS unsigned char* bu = lds + wave * SC_WAVE_BYTES;
    LAS unsigned char* hb = bu + 16 * SC_BU_ROW;
    LAS f32x2* sx = (LAS f32x2*)(lds + NWAVES * SC_WAVE_BYTES);
    const int fr = lane & 15, fq = lane >> 4;
    for (int item = gw; item < NB * SG * NCHUNK; item += NGW) {
        const int j = item & (NCHUNK - 1), bg = item / NCHUNK, g = bg & (SG - 1), b = bg / SG;
        const int lg = l * SG + g;
        const f32x2 lam = ((const f32x2*)(ws + WS_LAMB))[lg * SP + lane];
        const float nlamy = -lam.y;
        bf16x8 bfr[8];
        { const bf16x8* bfp = (const bf16x8*)(ws + WS_BF) + (size_t)lg * 8 * 64 + lane;
#pragma unroll
          for (int nt = 0; nt < 8; ++nt) bfr[nt] = bfp[nt * 64]; }
        bf16x8 cfr[4]; f32x4 dsk = (f32x4){0.f, 0.f, 0.f, 0.f};
        if (PASS == 2) { const bf16x8* cfp = (const bf16x8*)(ws + WS_CF) + (size_t)lg * 4 * 64 + lane;
#pragma unroll
          for (int kk = 0; kk < 4; ++kk) cfr[kk] = cfp[kk * 64];
          dsk = *(const f32x4*)(a.in[12] + lg * SGC + 4 * fq); }
        const int rowbase = b * SEQ + j * CHUNK;
        const bf16_t* ui = ubase + ((size_t)(b * SG + g) * SEQ + j * CHUNK) * SGC;
        const bf16_t* up = ui + fr * SGC + (fq & 1) * 8;
        const bf16_t* uq = ui + fr * SGC + 4 * fq;
        const size_t oo = (size_t)(rowbase + fr) * SW + g * SGC + 4 * fq;
        const u32x4 zz = (u32x4){0u, 0u, 0u, 0u};
        u32x4 cua[4]; u32x2 cuv[4];
#pragma unroll
        for (int q = 0; q < 4; ++q) { cua[q] = (fq < 2) ? *(const u32x4*)(up + (size_t)q * 16 * SGC) : zz; cuv[q] = (u32x2){0u, 0u}; if (PASS == 2) cuv[q] = *(const u32x2*)(uq + (size_t)q * 16 * SGC); }
        float hre = 0.f, him = 0.f;
        if (PASS == 2) {
            const f32x2 lt = ((const f32x2*)(ws + WS_LAMT))[lg * SP + lane];
            f32x2 sv[NCHUNK - 1];
#pragma unroll
            for (int i = 0; i < NCHUNK - 1; ++i) sv[i] = (i < j) ? (LDSX ? sx[i * SP + lane] : st[(size_t)(item - j + i) * SP + lane]) : (f32x2){0.f, 0.f};
#pragma unroll
            for (int i = 0; i < NCHUNK - 1; ++i) if (i < j) { const float nr = lt.x * hre - lt.y * him + sv[i].x, ni = lt.x * him + lt.y * hre + sv[i].y; hre = nr; him = ni; }
        }
#pragma unroll 1
        for (int grp = 0; grp < CHUNK / 64; ++grp) {
            const int ngrp = (grp + 1 < CHUNK / 64) ? grp + 1 : grp;
            u32x4 nua[4]; u32x2 nuv[4];
#pragma unroll
            for (int q = 0; q < 4; ++q) { nua[q] = (fq < 2) ? *(const u32x4*)(up + (size_t)(ngrp * 4 + q) * 16 * SGC) : zz; nuv[q] = (u32x2){0u, 0u}; if (PASS == 2) nuv[q] = *(const u32x2*)(uq + (size_t)(ngrp * 4 + q) * 16 * SGC); }
#pragma unroll
            for (int q = 0; q < 4; ++q) {
                const int sub = grp * 4 + q;
                const bf16x8 uf = __builtin_bit_cast(bf16x8, cua[q]);
                f32x4 dd[8];
#pragma unroll
                for (int nt = 0; nt < 8; ++nt) dd[nt] = __builtin_amdgcn_mfma_f32_16x16x32_bf16(bfr[nt], uf, (f32x4){0.f, 0.f, 0.f, 0.f}, 0, 0, 0);
                __builtin_amdgcn_sched_barrier(0);
#pragma unroll
                for (int nt = 0; nt < 8; ++nt) *(LAS f32x4*)(bu + fr * SC_BU_ROW + (8 * nt + 2 * fq) * 8) = dd[nt];
                f32x2 vbr[16];
#pragma unroll
                for (int s = 0; s < 16; ++s) vbr[s] = *(const LAS f32x2*)(bu + s * SC_BU_ROW + lane * 8);
#pragma unroll
                for (int s = 0; s < 16; ++s) {
                    const f32x2 v = vbr[s];
                    const float tr = __builtin_fmaf(nlamy, him, v.x), ti = __builtin_fmaf(lam.y, hre, v.y);
                    hre = __builtin_fmaf(lam.x, hre, tr); him = __builtin_fmaf(lam.x, him, ti);
                    if (PASS == 2) *(LAS unsigned*)(hb + s * SC_HB_ROW + lane * 4) = cvt_pk_bf16(hre, him);
                }
                if (PASS == 2) {
                    f32x4 y = (f32x4){0.f, 0.f, 0.f, 0.f};
#pragma unroll
                    for (int kk = 0; kk < 4; ++kk) { const bf16x8 hf = *(const LAS bf16x8*)(hb + fr * SC_HB_ROW + (32 * kk + 8 * fq) * 2); y = __builtin_amdgcn_mfma_f32_16x16x32_bf16(cfr[kk], hf, y, 0, 0, 0); }
                    const u32x2 uv = cuv[q];
                    const f32x4 uf4 = (f32x4){__uint_as_float(uv.x << 16), __uint_as_float(uv.x & 0xffff0000u), __uint_as_float(uv.y << 16), __uint_as_float(uv.y & 0xffff0000u)};
                    f32x4 ge; ge.x = geluf_(y.x + dsk.x * uf4.x); ge.y = geluf_(y.y + dsk.y * uf4.y); ge.z = geluf_(y.z + dsk.z * uf4.z); ge.w = geluf_(y.w + dsk.w * uf4.w);
                    st_bf16x4((bf16_t*)(ws + WS_GLUIN) + ((size_t)(b * SG + g) * SEQ + j * CHUNK + sub * 16 + fr) * SGC + 4 * fq, ge);
                }
                LDS_WAIT();
            }
#pragma unroll
            for (int q = 0; q < 4; ++q) { cua[q] = nua[q]; cuv[q] = nuv[q]; }
        }
        if (PASS == 1) { if (LDSX) sx[j * SP + lane] = (f32x2){hre, him}; else st[(size_t)item * SP + lane] = (f32x2){hre, him}; }
    }
}

__device__ __forceinline__ void phase_final(const Args& a, int gw, int NGW, int lane) {
    const float* ss = (const float*)(a.ws + WS_SS) + 2 * MTOK;
    const f32x4* gp = (const f32x4*)a.in[17] + lane;
    for (int row = gw; row < MTOK; row += NGW) {
        const float rs = rsqrtf(ss[row] * (1.0f / DM) + RMS_EPS);
        f32x4* xr = (f32x4*)(a.out + (size_t)row * DM) + lane;
#pragma unroll
        for (int j = 0; j < 8; ++j) xr[64 * j] = xr[64 * j] * rs * gp[64 * j];
    }
}

__global__ void __launch_bounds__(NTHREADS, 2) fwd_kernel(Args a) {
    extern __shared__ __attribute__((aligned(16))) unsigned char lds_raw[];
    LAS unsigned char* lds = (LAS unsigned char*)lds_raw;
    cg::grid_group grid = cg::this_grid();
    const int tid = threadIdx.x, lane = tid & 63, wave = __builtin_amdgcn_readfirstlane(tid >> 6);
    const int G = gridDim.x, gw = blockIdx.x * NWAVES + wave, NGW = G * NWAVES;
    unsigned char* ws = a.ws;
    const int lo = a.lo, hi = a.hi;
#define IN(k) (lo <= (k) && (k) < hi)
#if MK_XCDBAR
    volatile LAS unsigned* bst = (volatile LAS unsigned*)(lds + LDS_STAGE);
    if (tid < 4) bst[tid] = 0u;
    __syncthreads();
    XcdBarrier xbar = xcd_barrier_post((unsigned*)(ws + WS_CTL), bst);
#define SEAM(k) do { if (a.coop && IN(k) && IN((k) + 1)) { if (a.coop == 2) grid.sync(); else xcd_barrier(xbar); } } while (0)
#else
#define SEAM(k) do { if (a.coop && IN(k) && IN((k) + 1)) grid.sync(); } while (0)
#endif
#ifndef PROBE_REP
#define PROBE_REP -1
#endif
#define REPS(k) for (int rep = 0; rep < ((PROBE_REP == (k)) ? 2 : 1); ++rep)

    const bool fuse_final = MK_XCDBAR && a.coop && G == 256 && lo == 0 && hi == 14 && PROBE_REP != 6;
    if (IN(0)) REPS(0) { phase_prologue(a, lds, gw, NGW, wave, lane); }
    SEAM(0);
    for (int l = 0; l < DEPTH; ++l) {
        const int pb = 1 + 6 * l;
        float* ss = (float*)(ws + WS_SS);
        if (IN(pb + 0)) REPS(1) {
            pg8::Gemm g{(const bf16_t*)(ws + WS_XB), (const bf16_t*)(ws + WS_WIN) + (size_t)l * NIN * DM, MTOK, NIN, DM};
            pg8::StaticOrder S; S.init(MTOK, NIN, G, (int)blockIdx.x);
            EpiIn E{ss + (size_t)l * MTOK, a.in[3] + (size_t)l * 3 * CW, (bf16_t*)(ws + WS_AIN), (float*)(ws + WS_CV), (float*)(ws + WS_GATE), (bf16_t*)(ws + WS_U) + (size_t)l * MTOK * SW, (bf16_t*)(ws + WS_SZB), (unsigned char*)(ws + WS_SGA), (unsigned char*)(ws + WS_SGB)};
            pg8::gemm_phase<EpiIn>(lds, g, S, E);
        }
        SEAM(pb + 0);
        const bool scan_merged = a.coop && IN(pb + 1) && IN(pb + 2) && NGW == NB * SG * NCHUNK && NWAVES == NCHUNK && PROBE_REP != 2 && PROBE_REP != 3;
        if (IN(pb + 1)) REPS(2) {
            int tl = tid; asm volatile("" : "+v"(tl));
            phase_convfix(a, l, blockIdx.x * NTHREADS + tl, G * NTHREADS);
            if (scan_merged) phase_scan<1, true>(a, l, lds, gw, NGW, wave, tl & 63); else phase_scan<1, false>(a, l, lds, gw, NGW, wave, tl & 63);
        }
        if (scan_merged) { LDS_WAIT(); __syncthreads(); } else SEAM(pb + 1);
        if (IN(pb + 2)) REPS(3) {
            int tl = tid; asm volatile("" : "+v"(tl));
            if (scan_merged) phase_scan<2, true>(a, l, lds, gw, NGW, wave, tl & 63); else phase_scan<2, false>(a, l, lds, gw, NGW, wave, tl & 63);
        }
        SEAM(pb + 2);
        if (IN(pb + 3)) REPS(4) {
            pg8::Gemm g{(const bf16_t*)(ws + WS_GLUIN), (const bf16_t*)(ws + WS_WGLU) + (size_t)l * SW * SW, MTOK, SW, SW};
            EpiGluT<1> E{(const bf16_t*)(ws + WS_GLUIN), (const bf16_t*)(ws + WS_SZB), a.in[14] + l * SW, (bf16_t*)(ws + WS_BIN)};
            pg8::gemm_mhalf<EpiGluT<1>>(lds, g, G, (int)blockIdx.x, E);
        }
        SEAM(pb + 3);
        if (IN(pb + 4)) REPS(5) {
            pg8::Gemm ga{(const bf16_t*)(ws + WS_AIN), (const bf16_t*)(ws + WS_WA) + (size_t)l * DM * CW, MTOK, DM, CW};
            pg8::Gemm gb{(const bf16_t*)(ws + WS_BIN), (const bf16_t*)(ws + WS_WB) + (size_t)l * DM * SW, MTOK, DM, SW};
            pg8::StaticOrder S; S.init(MTOK, DM, G, (int)blockIdx.x);
            EpiMidAB Em{(const unsigned char*)(ws + WS_SGA), (const unsigned char*)(ws + WS_SGB)};
            EpiFinAB Ef{(const unsigned char*)(ws + WS_SGB), (bf16_t*)(ws + WS_M)};
            pg8::gemm_chain2<EpiMidAB, EpiFinAB>(lds, ga, gb, S, Em, Ef);
        }
        SEAM(pb + 4);
        if (IN(pb + 5)) REPS(6) {
            pg8::Gemm g{(const bf16_t*)(ws + WS_M), (const bf16_t*)(ws + WS_WO) + (size_t)l * DM * DM, MTOK, DM, DM};
            pg8::StaticOrder S; S.init(MTOK, DM, G, (int)blockIdx.x);
            if (l == DEPTH - 1 && fuse_final) {
                EpiOFin E{(const float*)(ws + WS_X1), a.out, ss + (size_t)(l + 1) * MTOK, a.in[17], xbar, (const bf16_t*)(ws + WS_XB), (const bf16_t*)(ws + WS_X1)};
                pg8::gemm_phase<EpiOFin>(lds, g, S, E);
            } else {
                EpiO E{l == 0 ? a.in[0] : (const float*)(ws + WS_X1), l == 0 ? (float*)(ws + WS_X1) : a.out, l == 0 ? (bf16_t*)(ws + WS_XB) : (bf16_t*)nullptr, rep == 0 ? ss + (size_t)(l + 1) * MTOK : (float*)nullptr, (l == 0 && fuse_final) ? (bf16_t*)(ws + WS_X1) : (bf16_t*)nullptr};
                pg8::gemm_phase<EpiO>(lds, g, S, E);
            }
        }
        if (!(l == DEPTH - 1 && fuse_final)) SEAM(pb + 5);
    }
    if (IN(13) && !fuse_final) phase_final(a, gw, NGW, lane);
#undef IN
#undef SEAM
}

extern "C" void kernel_launch(void* const* d_in, const int* in_sizes, int n_in, void* d_out, int out_size, void* d_ws, size_t ws_size, hipStream_t stream) {
    static int grid = 0;
    if (grid == 0) {
        if (n_in != 18 || ws_size < WS_END) { fprintf(stderr, "kernel_launch: unexpected n_in %d or ws %zu < %zu\n", n_in, ws_size, (size_t)WS_END); grid = -1; return; }
        int dev = 0, cus = 0, per_cu = 0;
        hipGetDevice(&dev);
        hipDeviceGetAttribute(&cus, hipDeviceAttributeMultiprocessorCount, dev);
        if (hipFuncSetAttribute((const void*)fwd_kernel, hipFuncAttributeMaxDynamicSharedMemorySize, LDS_BYTES) != hipSuccess) { fprintf(stderr, "kernel_launch: hipFuncSetAttribute failed\n"); }
        if (hipOccupancyMaxActiveBlocksPerMultiprocessor(&per_cu, (const void*)fwd_kernel, NTHREADS, LDS_BYTES) != hipSuccess || per_cu < 1) { fprintf(stderr, "kernel_launch: occupancy query says %d\n", per_cu); per_cu = 1; }
        (void)hipGetLastError();
        grid = cus * 1;
        fprintf(stderr, "kernel_launch: cus %d per_cu %d grid %d\n", cus, per_cu, grid);
    }
    if (grid < 0) return;
    hipMemsetAsync((char*)d_ws + WS_CTL, 0, CTL_BYTES, stream);
    Args a{};
    for (int i = 0; i < 18; ++i) a.in[i] = (const float*)d_in[i];
    a.out = (float*)d_out; a.ws = (unsigned char*)d_ws;
#if MK_MULTI
    for (int ph = 0; ph < 14; ++ph) {
        a.lo = ph; a.hi = ph + 1; a.coop = 0;
        hipLaunchKernelGGL(fwd_kernel, dim3(grid), dim3(NTHREADS), LDS_BYTES, stream, a);
    }
#else
    a.lo = 0; a.hi = 14; a.coop = 1;
    void* kargs[] = {&a};
    hipError_t e = hipLaunchCooperativeKernel((const void*)fwd_kernel, dim3(grid), dim3(NTHREADS), kargs, LDS_BYTES, stream);
    if (e != hipSuccess) fprintf(stderr, "cooperative launch failed: %s (grid %d)\n", hipGetErrorString(e), grid);
#endif
}
```

```cpp
#include <hip/hip_runtime.h>
#include <hip/hip_cooperative_groups.h>
#include <cstdio>
#include <cstdint>
namespace cg = cooperative_groups;

#ifndef MK_MULTI
#define MK_MULTI 0
#endif
#ifndef MK_XCDBAR
#define MK_XCDBAR 1
#endif

#define LAS __attribute__((address_space(3)))
typedef unsigned short bf16_t;
typedef short bf16x8 __attribute__((ext_vector_type(8)));
typedef float f32x4 __attribute__((ext_vector_type(4)));
typedef float f32x2 __attribute__((ext_vector_type(2)));
typedef unsigned u32x4 __attribute__((ext_vector_type(4)));
typedef unsigned u32x2 __attribute__((ext_vector_type(2)));

constexpr int DM = 2048, NB = 4, SEQ = 2048, MTOK = NB * SEQ, DEPTH = 2;
constexpr int NIN = 14336, CW = 2048, SW = 1024, SG = 64, SGC = 16, SP = 64;
constexpr int CHUNK = 256, NCHUNK = SEQ / CHUNK;
constexpr float RMS_EPS = 1e-6f;
constexpr int NWAVES = 8, NTHREADS = 512;
constexpr int LDS_STAGE = 131072, LDS_BYTES = LDS_STAGE + 16;

constexpr size_t AL(size_t x) { return (x + 255) & ~(size_t)255; }
constexpr size_t WS_CTL   = 0;
constexpr size_t CTL_BYTES = 16384;
constexpr size_t WS_SS    = WS_CTL + CTL_BYTES;
constexpr size_t WS_LAMB  = AL(WS_SS + (size_t)3 * MTOK * 4);
constexpr size_t WS_LAMT  = AL(WS_LAMB + (size_t)DEPTH * SG * SP * 8);
constexpr size_t WS_BF    = AL(WS_LAMT + (size_t)DEPTH * SG * SP * 8);
constexpr size_t WS_CF    = AL(WS_BF + (size_t)DEPTH * SG * 8 * 64 * 16);
constexpr size_t WS_WIN   = AL(WS_CF + (size_t)DEPTH * SG * 4 * 64 * 16);
constexpr size_t WS_WA    = AL(WS_WIN + (size_t)DEPTH * NIN * DM * 2);
constexpr size_t WS_WGLU  = AL(WS_WA + (size_t)DEPTH * DM * CW * 2);
constexpr size_t WS_WB    = AL(WS_WGLU + (size_t)DEPTH * SW * SW * 2);
constexpr size_t WS_WO    = AL(WS_WB + (size_t)DEPTH * DM * SW * 2);
constexpr size_t WS_XB    = AL(WS_WO + (size_t)DEPTH * DM * DM * 2);
constexpr size_t WS_CV    = AL(WS_XB + (size_t)MTOK * DM * 2);
constexpr size_t WS_GATE  = AL(WS_CV + (size_t)MTOK * CW * 2);
constexpr size_t WS_AIN   = AL(WS_GATE + (size_t)MTOK * CW * 2);
constexpr size_t WS_U     = AL(WS_AIN + (size_t)MTOK * CW * 2);
constexpr size_t WS_SZB   = AL(WS_U + (size_t)DEPTH * MTOK * SW * 4);
constexpr size_t WS_SGA   = AL(WS_SZB + (size_t)MTOK * SW * 2);
constexpr size_t WS_SGB   = AL(WS_SGA + (size_t)MTOK * DM * 2);
constexpr size_t WS_ST    = AL(WS_SGB + (size_t)MTOK * DM * 2);
constexpr size_t WS_GLUIN = AL(WS_ST + (size_t)NB * SG * NCHUNK * SP * 8);
constexpr size_t WS_BIN   = AL(WS_GLUIN + (size_t)MTOK * SW * 2);
constexpr size_t WS_MA    = AL(WS_BIN + (size_t)MTOK * SW * 2);
constexpr size_t WS_M     = AL(WS_MA + (size_t)MTOK * DM * 2);
constexpr size_t WS_X1    = AL(WS_M + (size_t)MTOK * DM * 2);
constexpr size_t WS_END   = AL(WS_X1 + (size_t)MTOK * DM * 4);

typedef __bf16 bf16x2v __attribute__((ext_vector_type(2)));
__device__ __forceinline__ unsigned cvt_pk_bf16(float lo, float hi) { const f32x2 v = {lo, hi}; return __builtin_bit_cast(unsigned, __builtin_convertvector(v, bf16x2v)); }
__device__ __forceinline__ f32x4 ld_bf16x4(const bf16_t* p) { const u32x2 w = *(const u32x2*)p; f32x4 r; r.x = __uint_as_float(w.x << 16); r.y = __uint_as_float(w.x & 0xffff0000u); r.z = __uint_as_float(w.y << 16); r.w = __uint_as_float(w.y & 0xffff0000u); return r; }
__device__ __forceinline__ void st_bf16x4(bf16_t* p, f32x4 v) { u32x2 w; w.x = cvt_pk_bf16(v.x, v.y); w.y = cvt_pk_bf16(v.z, v.w); *(u32x2*)p = w; }
typedef __amdgpu_buffer_rsrc_t rsrc_t;
__device__ __forceinline__ rsrc_t mk_rsrc(const void* p) { return __builtin_amdgcn_make_buffer_rsrc((void*)p, 0, 0x7fffffff, 0x00020000); }
__device__ __forceinline__ void wt_bf16x8(rsrc_t r, size_t elem, f32x4 a, f32x4 b) { u32x4 w; w.x = cvt_pk_bf16(a.x, a.y); w.y = cvt_pk_bf16(a.z, a.w); w.z = cvt_pk_bf16(b.x, b.y); w.w = cvt_pk_bf16(b.z, b.w); __builtin_amdgcn_raw_buffer_store_b128(w, r, (int)(elem * 2), 0, 16); }
__device__ __forceinline__ void wt_bf16x4(rsrc_t r, size_t elem, f32x4 a) { u32x2 w; w.x = cvt_pk_bf16(a.x, a.y); w.y = cvt_pk_bf16(a.z, a.w); __builtin_amdgcn_raw_buffer_store_b64(w, r, (int)(elem * 2), 0, 16); }
__device__ __forceinline__ void wt_u32x2(rsrc_t r, size_t byteoff, u32x2 w) { __builtin_amdgcn_raw_buffer_store_b64(w, r, (int)byteoff, 0, 16); }
struct F8 { f32x4 lo, hi; };
__device__ __forceinline__ F8 ld_bf16x8(const bf16_t* p) { const u32x4 w = *(const u32x4*)p; F8 r;
    r.lo = (f32x4){__uint_as_float(w.x << 16), __uint_as_float(w.x & 0xffff0000u), __uint_as_float(w.y << 16), __uint_as_float(w.y & 0xffff0000u)};
    r.hi = (f32x4){__uint_as_float(w.z << 16), __uint_as_float(w.z & 0xffff0000u), __uint_as_float(w.w << 16), __uint_as_float(w.w & 0xffff0000u)}; return r; }
__device__ __forceinline__ void st_bf16x8(bf16_t* p, f32x4 a, f32x4 b) { u32x4 w; w.x = cvt_pk_bf16(a.x, a.y); w.y = cvt_pk_bf16(a.z, a.w); w.z = cvt_pk_bf16(b.x, b.y); w.w = cvt_pk_bf16(b.z, b.w); *(u32x4*)p = w; }
__device__ __forceinline__ float sigmoidf_(float x) { return __builtin_amdgcn_rcpf(1.0f + __expf(-x)); }
__device__ __forceinline__ float siluf_(float x) { return x * __builtin_amdgcn_rcpf(1.0f + __expf(-x)); }
__device__ __forceinline__ float geluf_(float x) { const float z = 0.7978845608028654f * (x + 0.044715f * x * x * x); const float t = 1.0f - 2.0f * __builtin_amdgcn_rcpf(1.0f + __expf(2.0f * z)); return 0.5f * x * (1.0f + t); }
__device__ __forceinline__ f32x4 sig4(f32x4 v) { f32x4 r; r.x = sigmoidf_(v.x); r.y = sigmoidf_(v.y); r.z = sigmoidf_(v.z); r.w = sigmoidf_(v.w); return r; }
__device__ __forceinline__ f32x4 silu4(f32x4 v) { f32x4 r; r.x = siluf_(v.x); r.y = siluf_(v.y); r.z = siluf_(v.z); r.w = siluf_(v.w); return r; }
__device__ __forceinline__ float wave_sum(float v) {
#pragma unroll
    for (int o = 1; o < 64; o <<= 1) v += __shfl_xor(v, o);
    return v;
}
template <int CTRL> __device__ __forceinline__ float dppf(float x) { return __builtin_bit_cast(float, __builtin_amdgcn_update_dpp(0, __builtin_bit_cast(int, x), CTRL, 0xf, 0xf, true)); }
template <int CTRL> __device__ __forceinline__ f32x4 dpp4(f32x4 v) { f32x4 r; r.x = dppf<CTRL>(v.x); r.y = dppf<CTRL>(v.y); r.z = dppf<CTRL>(v.z); r.w = dppf<CTRL>(v.w); return r; }
#define LDS_WAIT() asm volatile("s_waitcnt lgkmcnt(0)" ::: "memory")

namespace pg8 {
constexpr int BM = 256, BK = 64, HALF = 128, HTB = HALF * BK * 2, STAGE_BYTES = 8 * HTB, NXCD = 8, WGM = 4;
__host__ __device__ __forceinline__ int lds_byte(int r, int c) { const int st = (r >> 4) * 2 + (c >> 5), rr = r & 15, cc = c & 31, ob = rr * 64 + cc * 2; return st * 1024 + (ob ^ (((ob >> 9) & 1) << 5)); }
__host__ __device__ __forceinline__ void stage_rc(int b, int& R, int& C) { const int st = b / 1024, sb = b % 1024, swz = sb ^ (((sb >> 9) & 1) << 5); R = (st >> 1) * 16 + swz / 64; C = (st & 1) * 32 + (swz % 64) / 2; }
struct Unit { int pm, pn; };
struct Gemm { const bf16_t* A; const bf16_t* Bt; int M, N, K; };
struct StaticOrder {
    int nM, nN, nwg, G, c;
    __host__ __device__ void init(int M, int N, int G_, int c_) { nM = M / BM; nN = N / BM; nwg = nM * nN; G = G_; c = c_; }
    __host__ __device__ bool next(int i, Unit& u) const {
        const long L = (long)i * G + c; if (L >= nwg) return false;
        int wgid = (int)L; { const int q = nwg / NXCD, r = nwg % NXCD, xcd = wgid % NXCD, off = wgid / NXCD; wgid = (xcd < r ? xcd * (q + 1) : r * (q + 1) + (xcd - r) * q) + off; }
        const int nig = WGM * nN, gid = wgid / nig, fm = gid * WGM, gsz = (nM - fm) < WGM ? (nM - fm) : WGM;
        u.pm = fm + ((wgid % nig) % gsz); u.pn = (wgid % nig) / gsz; return true;
    }
};

template <class Epi>
__device__ __forceinline__ void gemm_phase(LAS unsigned char* lds, const Gemm g, const StaticOrder& S, const Epi& E) {
    int tid = threadIdx.x; asm volatile("" : "+v"(tid));
    const int wid = __builtin_amdgcn_readfirstlane(tid >> 6), lane = tid & 63, wr = wid >> 2, wc = wid & 3, fr = lane & 15, fq = lane >> 4;
    const int K = g.K, nt = K / BK;
    unsigned voffA[2];
#pragma unroll
    for (int i = 0; i < 2; ++i) { int R, C; stage_rc(tid * 16 + i * 8192, R, C); voffA[i] = (unsigned)(R * K + C) * 2u; }
    const size_t kstep = (size_t)(BK * 2);
    const size_t hstep = (size_t)HALF * K * 2;
    const size_t tstep = 2 * hstep;
    const unsigned ldsw = (unsigned)wid * 1024u;
    const int aoff = lds_byte(wr * 64 + fr, fq * 8), boff = lds_byte(wc * 32 + fr, fq * 8);
#define PG8_SA(b, h) (((b) * 2 + (h)) * HTB)
#define PG8_SB(b, h) ((4 + (b) * 2 + (h)) * HTB)
#define PG8_STAGE(bufoff, gbase) do { _Pragma("unroll") for (int _i = 0; _i < 2; ++_i) \
        __builtin_amdgcn_global_load_lds((const unsigned*)((const char*)(gbase) + voffA[_i]), (LAS unsigned*)(lds + (bufoff) + ldsw + _i * 8192), 16, 0, 0); } while (0)
#define PG8_LDA(dst, b, h) do { _Pragma("unroll") for (int m = 0; m < 4; ++m) _Pragma("unroll") for (int k = 0; k < 2; ++k) dst[m][k] = *(const LAS bf16x8*)(lds + PG8_SA(b, h) + aoff + m * 2048 + k * 1024); } while (0)
#define PG8_LDB(dst, b, h) do { _Pragma("unroll") for (int n = 0; n < 2; ++n) _Pragma("unroll") for (int k = 0; k < 2; ++k) dst[n][k] = *(const LAS bf16x8*)(lds + PG8_SB(b, h) + boff + n * 2048 + k * 1024); } while (0)
#define PG8_MMA(ai, bj, At, Bt) do { __builtin_amdgcn_s_setprio(1); _Pragma("unroll") for (int m = 0; m < 4; ++m) _Pragma("unroll") for (int n = 0; n < 2; ++n) _Pragma("unroll") for (int k = 0; k < 2; ++k) \
        acc[ai][bj][m][n] = __builtin_amdgcn_mfma_f32_16x16x32_bf16(Bt[n][k], At[m][k], acc[ai][bj][m][n], 0, 0, 0); __builtin_amdgcn_s_setprio(0); } while (0)
#define PG8_WAIT_V(n) asm volatile("s_waitcnt vmcnt(" #n ")" ::: "memory")
#define PG8_WAIT_L(n) asm volatile("s_waitcnt lgkmcnt(" #n ")" ::: "memory")
#define PG8_BAR __builtin_amdgcn_s_barrier()
#define PG8_SCHED __builtin_amdgcn_sched_barrier(0)
    Unit cur, nxt; int ui = 0;
    if (!S.next(0, cur)) return;
    f32x4 acc[2][2][4][2];
#pragma unroll
    for (int a = 0; a < 2; ++a)
#pragma unroll
        for (int b = 0; b < 2; ++b)
#pragma unroll
            for (int m = 0; m < 4; ++m)
#pragma unroll
                for (int n = 0; n < 2; ++n) acc[a][b][m][n] = (f32x4){0.f, 0.f, 0.f, 0.f};
    bf16x8 At[4][2], B0[2][2], B1[2][2];
    const char* cA = (const char*)g.A + (size_t)cur.pm * tstep; const char* cB = (const char*)g.Bt + (size_t)cur.pn * tstep;
    float pre[8];
    E.prefetch(cur, wr, fr, pre);
    PG8_STAGE(PG8_SB(0, 0), cB); PG8_STAGE(PG8_SB(0, 1), cB + hstep); PG8_STAGE(PG8_SA(0, 0), cA); PG8_STAGE(PG8_SA(0, 1), cA + hstep);
    if (wr == 1) PG8_BAR;
    PG8_WAIT_V(2); PG8_BAR;
    PG8_STAGE(PG8_SB(1, 0), cB + kstep); PG8_STAGE(PG8_SA(1, 0), cA + kstep); PG8_STAGE(PG8_SB(1, 1), cB + hstep + kstep);
    PG8_WAIT_V(6); PG8_BAR;
    for (;;) {
        const bool has_next = S.next(ui + 1, nxt);
        const char* nA = has_next ? (const char*)g.A + (size_t)nxt.pm * tstep : cA; const char* nB = has_next ? (const char*)g.Bt + (size_t)nxt.pn * tstep : cB;
        for (int t = 0; t < nt; t += 2) {
            const bool last = (t == nt - 2);
            const char* a1 = cA + (size_t)(t + 1) * kstep;
            const char* a2 = last ? nA : cA + (size_t)(t + 2) * kstep; const char* b2 = last ? nB : cB + (size_t)(t + 2) * kstep;
            const char* a3 = a2 + kstep; const char* b3 = b2 + kstep;
            PG8_LDB(B0, 0, 0); PG8_LDB(B1, 0, 1); PG8_SCHED; PG8_LDA(At, 0, 0); PG8_STAGE(PG8_SA(1, 1), a1 + hstep);
            PG8_WAIT_V(8); PG8_WAIT_L(0); PG8_BAR; PG8_MMA(0, 0, At, B0); PG8_MMA(0, 1, At, B1); PG8_BAR; PG8_SCHED;
            PG8_LDA(At, 0, 1); PG8_STAGE(PG8_SB(0, 0), b2); PG8_STAGE(PG8_SB(0, 1), b2 + hstep); PG8_STAGE(PG8_SA(0, 0), a2);
            PG8_WAIT_V(8); PG8_WAIT_L(0); PG8_BAR; PG8_MMA(1, 0, At, B0); PG8_MMA(1, 1, At, B1); PG8_BAR; PG8_SCHED;
            PG8_LDB(B0, 1, 0); PG8_LDB(B1, 1, 1); PG8_SCHED; PG8_LDA(At, 1, 0); PG8_STAGE(PG8_SA(0, 1), a2 + hstep);
            PG8_WAIT_V(8); PG8_WAIT_L(0); PG8_BAR; PG8_MMA(0, 0, At, B0); PG8_MMA(0, 1, At, B1); PG8_BAR; PG8_SCHED;
            PG8_LDA(At, 1, 1); PG8_STAGE(PG8_SB(1, 0), b3); PG8_STAGE(PG8_SB(1, 1), b3 + hstep); PG8_STAGE(PG8_SA(1, 0), a3);
            PG8_WAIT_V(8); PG8_WAIT_L(0); PG8_BAR; PG8_MMA(1, 0, At, B0); PG8_MMA(1, 1, At, B1); PG8_BAR; PG8_SCHED;
        }
        if (wr == 0) PG8_BAR;
        E(acc, cur, wr, wc, fr, fq, pre);
        if (has_next) E.prefetch(nxt, wr, fr, pre);
        if (!has_next) break;
#pragma unroll
        for (int a = 0; a < 2; ++a)
#pragma unroll
            for (int b = 0; b < 2; ++b)
#pragma unroll
                for (int m = 0; m < 4; ++m)
#pragma unroll
                    for (int n = 0; n < 2; ++n) acc[a][b][m][n] = (f32x4){0.f, 0.f, 0.f, 0.f};
        cur = nxt; cA = nA; cB = nB; ++ui;
        if (wr == 1) PG8_BAR;
    }
    PG8_WAIT_V(0);
    PG8_BAR;
#undef PG8_SA
#undef PG8_SB
#undef PG8_STAGE
#undef PG8_LDA
#undef PG8_LDB
#undef PG8_MMA
#undef PG8_WAIT_V
#undef PG8_WAIT_L
#undef PG8_BAR
#undef PG8_SCHED
}
template <class EpiMid, class EpiFin>
__device__ __forceinline__ void gemm_chain2(LAS unsigned char* lds, const Gemm g0, const Gemm g1, const StaticOrder& S, const EpiMid& Emid, const EpiFin& Efin) {
    int tid = threadIdx.x; asm volatile("" : "+v"(tid));
    const int wid = __builtin_amdgcn_readfirstlane(tid >> 6), lane = tid & 63, wr = wid >> 2, wc = wid & 3, fr = lane & 15, fq = lane >> 4;
    unsigned vo[2][2];
#pragma unroll
    for (int i = 0; i < 2; ++i) { int R, C; stage_rc(tid * 16 + i * 8192, R, C); vo[0][i] = (unsigned)(R * g0.K + C) * 2u; vo[1][i] = (unsigned)(R * g1.K + C) * 2u; }
    const size_t kstep = (size_t)(BK * 2);
    const size_t hs0 = (size_t)HALF * g0.K * 2, hs1 = (size_t)HALF * g1.K * 2;
    const unsigned ldsw = (unsigned)wid * 1024u;
    const int aoff = lds_byte(wr * 64 + fr, fq * 8), boff = lds_byte(wc * 32 + fr, fq * 8);
#define PG8_SA(b, h) (((b) * 2 + (h)) * HTB)
#define PG8_SB(b, h) ((4 + (b) * 2 + (h)) * HTB)
#define PG8_STAGE(bufoff, gbase, v0, v1) do { \
        __builtin_amdgcn_global_load_lds((const unsigned*)((const char*)(gbase) + (v0)), (LAS unsigned*)(lds + (bufoff) + ldsw), 16, 0, 0); \
        __builtin_amdgcn_global_load_lds((const unsigned*)((const char*)(gbase) + (v1)), (LAS unsigned*)(lds + (bufoff) + ldsw + 8192), 16, 0, 0); } while (0)
#define PG8_LDA(dst, b, h) do { _Pragma("unroll") for (int m = 0; m < 4; ++m) _Pragma("unroll") for (int k = 0; k < 2; ++k) dst[m][k] = *(const LAS bf16x8*)(lds + PG8_SA(b, h) + aoff + m * 2048 + k * 1024); } while (0)
#define PG8_LDB(dst, b, h) do { _Pragma("unroll") for (int n = 0; n < 2; ++n) _Pragma("unroll") for (int k = 0; k < 2; ++k) dst[n][k] = *(const LAS bf16x8*)(lds + PG8_SB(b, h) + boff + n * 2048 + k * 1024); } while (0)
#define PG8_MMA(ai, bj, At, Bt) do { __builtin_amdgcn_s_setprio(1); _Pragma("unroll") for (int m = 0; m < 4; ++m) _Pragma("unroll") for (int n = 0; n < 2; ++n) _Pragma("unroll") for (int k = 0; k < 2; ++k) \
        acc[ai][bj][m][n] = __builtin_amdgcn_mfma_f32_16x16x32_bf16(Bt[n][k], At[m][k], acc[ai][bj][m][n], 0, 0, 0); __builtin_amdgcn_s_setprio(0); } while (0)
#define PG8_WAIT_V(n) asm volatile("s_waitcnt vmcnt(" #n ")" ::: "memory")
#define PG8_WAIT_L(n) asm volatile("s_waitcnt lgkmcnt(" #n ")" ::: "memory")
#define PG8_BAR __builtin_amdgcn_s_barrier()
#define PG8_SCHED __builtin_amdgcn_sched_barrier(0)
    Unit cur, nxt; int ui = 0;
    if (!S.next(0, cur)) return;
    f32x4 acc[2][2][4][2];
#pragma unroll
    for (int a = 0; a < 2; ++a)
#pragma unroll
        for (int b = 0; b < 2; ++b)
#pragma unroll
            for (int m = 0; m < 4; ++m)
#pragma unroll
                for (int n = 0; n < 2; ++n) acc[a][b][m][n] = (f32x4){0.f, 0.f, 0.f, 0.f};
    bf16x8 At[4][2], B0[2][2], B1[2][2];
    int seg = 0;
    const char* cA = (const char*)g0.A + (size_t)cur.pm * 2 * hs0; const char* cB = (const char*)g0.Bt + (size_t)cur.pn * 2 * hs0;
    PG8_STAGE(PG8_SB(0, 0), cB, vo[0][0], vo[0][1]); PG8_STAGE(PG8_SB(0, 1), cB + hs0, vo[0][0], vo[0][1]); PG8_STAGE(PG8_SA(0, 0), cA, vo[0][0], vo[0][1]); PG8_STAGE(PG8_SA(0, 1), cA + hs0, vo[0][0], vo[0][1]);
    if (wr == 1) PG8_BAR;
    PG8_WAIT_V(2); PG8_BAR;
    PG8_STAGE(PG8_SB(1, 0), cB + kstep, vo[0][0], vo[0][1]); PG8_STAGE(PG8_SA(1, 0), cA + kstep, vo[0][0], vo[0][1]); PG8_STAGE(PG8_SB(1, 1), cB + hs0 + kstep, vo[0][0], vo[0][1]);
    PG8_WAIT_V(6); PG8_BAR;
    for (;;) {
        const bool has_next = S.next(ui + 1, nxt);
        const int nt = (seg ? g1.K : g0.K) / BK;
        const size_t hsc = seg ? hs1 : hs0;
        const unsigned c0 = seg ? vo[1][0] : vo[0][0], c1 = seg ? vo[1][1] : vo[0][1];
        const bool wrap = (seg == 1) && !has_next;
        const int nseg = wrap ? seg : (seg ^ 1);
        const size_t hsn = nseg ? hs1 : hs0;
        const unsigned n0 = nseg ? vo[1][0] : vo[0][0], n1 = nseg ? vo[1][1] : vo[0][1];
        const Unit& nu = (seg == 0) ? cur : nxt;
        const char* nA = wrap ? cA : (nseg ? (const char*)g1.A + (size_t)nu.pm * 2 * hs1 : (const char*)g0.A + (size_t)nu.pm * 2 * hs0);
        const char* nB = wrap ? cB : (nseg ? (const char*)g1.Bt + (size_t)nu.pn * 2 * hs1 : (const char*)g0.Bt + (size_t)nu.pn * 2 * hs0);
        for (int t = 0; t < nt; t += 2) {
            const bool last = (t == nt - 2);
            const char* a1 = cA + (size_t)(t + 1) * kstep;
            const char* a2 = last ? nA : cA + (size_t)(t + 2) * kstep; const char* b2 = last ? nB : cB + (size_t)(t + 2) * kstep;
            const char* a3 = a2 + kstep; const char* b3 = b2 + kstep;
            const size_t hs2 = last ? hsn : hsc; const unsigned x0 = last ? n0 : c0, x1 = last ? n1 : c1;
            PG8_LDB(B0, 0, 0); PG8_LDB(B1, 0, 1); PG8_SCHED; PG8_LDA(At, 0, 0); PG8_STAGE(PG8_SA(1, 1), a1 + hsc, c0, c1);
            PG8_WAIT_V(8); PG8_WAIT_L(0); PG8_BAR; PG8_MMA(0, 0, At, B0); PG8_MMA(0, 1, At, B1); PG8_BAR; PG8_SCHED;
            PG8_LDA(At, 0, 1); PG8_STAGE(PG8_SB(0, 0), b2, x0, x1); PG8_STAGE(PG8_SB(0, 1), b2 + hs2, x0, x1); PG8_STAGE(PG8_SA(0, 0), a2, x0, x1);
            PG8_WAIT_V(8); PG8_WAIT_L(0); PG8_BAR; PG8_MMA(1, 0, At, B0); PG8_MMA(1, 1, At, B1); PG8_BAR; PG8_SCHED;
            PG8_LDB(B0, 1, 0); PG8_LDB(B1, 1, 1); PG8_SCHED; PG8_LDA(At, 1, 0); PG8_STAGE(PG8_SA(0, 1), a2 + hs2, x0, x1);
            PG8_WAIT_V(8); PG8_WAIT_L(0); PG8_BAR; PG8_MMA(0, 0, At, B0); PG8_MMA(0, 1, At, B1); PG8_BAR; PG8_SCHED;
            PG8_LDA(At, 1, 1); PG8_STAGE(PG8_SB(1, 0), b3, x0, x1); PG8_STAGE(PG8_SB(1, 1), b3 + hs2, x0, x1); PG8_STAGE(PG8_SA(1, 0), a3, x0, x1);
            PG8_WAIT_V(8); PG8_WAIT_L(0); PG8_BAR; PG8_MMA(1, 0, At, B0); PG8_MMA(1, 1, At, B1); PG8_BAR; PG8_SCHED;
        }
        if (wr == 0) PG8_BAR;
        if (seg == 0) Emid(acc, cur, wr, wc, fr, fq); else Efin(acc, cur, wr, wc, fr, fq);
        if (wrap) break;
        if (seg == 1) {
#pragma unroll
            for (int a = 0; a < 2; ++a)
#pragma unroll
                for (int b = 0; b < 2; ++b)
#pragma unroll
                    for (int m = 0; m < 4; ++m)
#pragma unroll
                        for (int n = 0; n < 2; ++n) acc[a][b][m][n] = (f32x4){0.f, 0.f, 0.f, 0.f};
            cur = nxt; ++ui;
        }
        cA = nA; cB = nB; seg = nseg;
        if (wr == 1) PG8_BAR;
    }
    PG8_WAIT_V(0);
    PG8_BAR;
#undef PG8_SA
#undef PG8_SB
#undef PG8_STAGE
#undef PG8_LDA
#undef PG8_LDB
#undef PG8_MMA
#undef PG8_WAIT_V
#undef PG8_WAIT_L
#undef PG8_BAR
#undef PG8_SCHED
}
template <class Epi>
__device__ __forceinline__ void gemm_mhalf(LAS unsigned char* lds, const Gemm g, int G, int c, const Epi& E) {
    int tid = threadIdx.x; asm volatile("" : "+v"(tid));
    const int wid = __builtin_amdgcn_readfirstlane(tid >> 6), lane = tid & 63, wr = wid >> 2, wc = wid & 3, fr = lane & 15, fq = lane >> 4;
    const int K = g.K, nt = K / BK, nN = g.N / BM, nU = (g.M / HALF) * nN;
    unsigned voffA[2], voffG[2];
#pragma unroll
    for (int i = 0; i < 2; ++i) { int R, C; stage_rc(tid * 16 + i * 8192, R, C); voffA[i] = (unsigned)(R * K + C) * 2u; voffG[i] = (unsigned)(R * 32 + (C >> 4) * 65536 + (C & 15) * 2); }
    const size_t kstep = (size_t)(BK * 2), kstepA = (size_t)4 * 65536;
    const size_t hstep = (size_t)HALF * K * 2;
    const unsigned ldsw = (unsigned)wid * 1024u;
    const int aoff = lds_byte(wr * 64 + fr, fq * 8), boff = lds_byte(wc * 32 + fr, fq * 8);
#define PG8_SA(b, h) (((b) * 2 + (h)) * HTB)
#define PG8_SB(b, h) ((4 + (b) * 2 + (h)) * HTB)
#define PG8_STAGE(bufoff, gbase) do { _Pragma("unroll") for (int _i = 0; _i < 2; ++_i) \
        __builtin_amdgcn_global_load_lds((const unsigned*)((const char*)(gbase) + voffA[_i]), (LAS unsigned*)(lds + (bufoff) + ldsw + _i * 8192), 16, 0, 0); } while (0)
#define PG8_STAGE_A(bufoff, gbase) do { _Pragma("unroll") for (int _i = 0; _i < 2; ++_i) \
        __builtin_amdgcn_global_load_lds((const unsigned*)((const char*)(gbase) + voffG[_i]), (LAS unsigned*)(lds + (bufoff) + ldsw + _i * 8192), 16, 0, 0); } while (0)
#define PG8_LDA(dst, b, h) do { _Pragma("unroll") for (int m = 0; m < 4; ++m) _Pragma("unroll") for (int k = 0; k < 2; ++k) dst[m][k] = *(const LAS bf16x8*)(lds + PG8_SA(b, h) + aoff + m * 2048 + k * 1024); } while (0)
#define PG8_LDB(dst, b, h) do { _Pragma("unroll") for (int n = 0; n < 2; ++n) _Pragma("unroll") for (int k = 0; k < 2; ++k) dst[n][k] = *(const LAS bf16x8*)(lds + PG8_SB(b, h) + boff + n * 2048 + k * 1024); } while (0)
#define PG8_MMA(ai, bj, At, Bt) do { __builtin_amdgcn_s_setprio(1); _Pragma("unroll") for (int m = 0; m < 4; ++m) _Pragma("unroll") for (int n = 0; n < 2; ++n) _Pragma("unroll") for (int k = 0; k < 2; ++k) \
        acc[ai][bj][m][n] = __builtin_amdgcn_mfma_f32_16x16x32_bf16(Bt[n][k], At[m][k], acc[ai][bj][m][n], 0, 0, 0); __builtin_amdgcn_s_setprio(0); } while (0)
#define PG8_WAIT_V(n) asm volatile("s_waitcnt vmcnt(" #n ")" ::: "memory")
#define PG8_WAIT_L(n) asm volatile("s_waitcnt lgkmcnt(" #n ")" ::: "memory")
#define PG8_BAR __builtin_amdgcn_s_barrier()
#define PG8_SCHED __builtin_amdgcn_sched_barrier(0)
    int ui = 0;
    if (c >= nU) return;
    Unit cur{c / nN, c % nN}, nxt{0, 0};
    f32x4 acc[2][2][4][2];
#pragma unroll
    for (int a = 0; a < 2; ++a)
#pragma unroll
        for (int b = 0; b < 2; ++b)
#pragma unroll
            for (int m = 0; m < 4; ++m)
#pragma unroll
                for (int n = 0; n < 2; ++n) acc[a][b][m][n] = (f32x4){0.f, 0.f, 0.f, 0.f};
    bf16x8 At[4][2], B0[2][2], B1[2][2];
#define PG8_ABASE(u) ((const char*)g.A + ((size_t)(((u).pm * HALF) >> 11) * (K / 16) * 2048 + (((u).pm * HALF) & 2047)) * 32)
    const char* cA = PG8_ABASE(cur); const char* cB = (const char*)g.Bt + (size_t)cur.pn * 2 * hstep;
    PG8_STAGE(PG8_SB(0, 0), cB); PG8_STAGE(PG8_SB(0, 1), cB + hstep); PG8_STAGE_A(PG8_SA(0, 0), cA);
    if (wr == 1) PG8_BAR;
    PG8_WAIT_V(0); PG8_BAR;
    PG8_STAGE(PG8_SB(1, 0), cB + kstep); PG8_STAGE(PG8_SB(1, 1), cB + hstep + kstep); PG8_STAGE_A(PG8_SA(1, 0), cA + kstepA);
    PG8_BAR;
    for (;;) {
        const long Ln = (long)(ui + 1) * G + c; const bool has_next = Ln < nU;
        if (has_next) { nxt.pm = (int)(Ln / nN); nxt.pn = (int)(Ln % nN); }
        const char* nA = has_next ? PG8_ABASE(nxt) : cA; const char* nB = has_next ? (const char*)g.Bt + (size_t)nxt.pn * 2 * hstep : cB;
        for (int t = 0; t < nt; t += 2) {
            const bool last = (t == nt - 2);
            const char* a2 = last ? nA : cA + (size_t)(t + 2) * kstepA; const char* b2 = last ? nB : cB + (size_t)(t + 2) * kstep;
            const char* a3 = a2 + kstepA; const char* b3 = b2 + kstep;
            PG8_LDB(B0, 0, 0); PG8_LDB(B1, 0, 1); PG8_SCHED; PG8_LDA(At, 0, 0);
            PG8_WAIT_L(0); PG8_BAR; PG8_MMA(0, 0, At, B0); PG8_MMA(0, 1, At, B1); PG8_BAR; PG8_SCHED;
            PG8_STAGE(PG8_SB(0, 0), b2); PG8_STAGE(PG8_SB(0, 1), b2 + hstep); PG8_STAGE_A(PG8_SA(0, 0), a2);
            PG8_WAIT_V(6); PG8_BAR; PG8_BAR; PG8_SCHED;
            PG8_LDB(B0, 1, 0); PG8_LDB(B1, 1, 1); PG8_SCHED; PG8_LDA(At, 1, 0);
            PG8_WAIT_L(0); PG8_BAR; PG8_MMA(0, 0, At, B0); PG8_MMA(0, 1, At, B1); PG8_BAR; PG8_SCHED;
            PG8_STAGE(PG8_SB(1, 0), b3); PG8_STAGE(PG8_SB(1, 1), b3 + hstep); PG8_STAGE_A(PG8_SA(1, 0), a3);
            PG8_WAIT_V(6); PG8_BAR; PG8_BAR; PG8_SCHED;
        }
        if (wr == 0) PG8_BAR;
        E(acc, cur, wr, wc, fr, fq);
        if (!has_next) break;
#pragma unroll
        for (int b = 0; b < 2; ++b)
#pragma unroll
            for (int m = 0; m < 4; ++m)
#pragma unroll
                for (int n = 0; n < 2; ++n) acc[0][b][m][n] = (f32x4){0.f, 0.f, 0.f, 0.f};
        cur = nxt; cA = nA; cB = nB; ++ui;
        if (wr == 1) PG8_BAR;
    }
    PG8_WAIT_V(0);
    PG8_BAR;
#undef PG8_SA
#undef PG8_SB
#undef PG8_STAGE
#undef PG8_STAGE_A
#undef PG8_ABASE
#undef PG8_LDA
#undef PG8_LDB
#undef PG8_MMA
#undef PG8_WAIT_V
#undef PG8_WAIT_L
#undef PG8_BAR
#undef PG8_SCHED
}
}

#define XB_TMO      128
#define XB_XCNT(j)  (256  + 64 * (j))
#define XB_XSUB(j)  (1280 + 64 * (j))
#define XB_XGEN(j)  (2304 + 64 * (j))
#define XB_TOP      3328
#define XB_TOPGEN   3392
#define XCD_BAR_WORDS 3456
#define XB_SPIN_CAP (1u << 18)
__device__ __forceinline__ unsigned xb_ld(unsigned* p)              { return __hip_atomic_load(p, __ATOMIC_RELAXED, __HIP_MEMORY_SCOPE_AGENT); }
__device__ __forceinline__ unsigned xb_add(unsigned* p, unsigned v) { return __hip_atomic_fetch_add(p, v, __ATOMIC_RELAXED, __HIP_MEMORY_SCOPE_AGENT); }
__device__ __forceinline__ unsigned xb_xcc_id() { return (unsigned)__builtin_amdgcn_s_getreg((3 << 11) | 20) & 0xFu; }
#define XB_SPIN(cond, bar) do { unsigned _sp = 0; while (cond) { __builtin_amdgcn_s_sleep(1); \
    if ((++_sp & 255u) == 0u) { if (xb_ld(&(bar)[XB_TMO])) break; if (_sp > XB_SPIN_CAP) { atomicAdd(&(bar)[XB_TMO], 1u); break; } } } } while (0)
struct XcdBarrier { unsigned* bar; unsigned x; volatile LAS unsigned* st; };
__device__ __forceinline__ XcdBarrier xcd_barrier_post(unsigned* bar, volatile LAS unsigned* st) {
    XcdBarrier b; b.bar = bar; b.x = xb_xcc_id(); b.st = st;
    if (threadIdx.x == 0) (void)xb_add(&bar[XB_XCNT(b.x)], 1u);
    return b;
}
__device__ __forceinline__ void xcd_barrier_complete(unsigned* bar, unsigned x, unsigned& nloc, unsigned& nx) {
    const unsigned G = gridDim.x * gridDim.y * gridDim.z;
    unsigned sum, cnt, mine, sp = 0u;
    for (;;) {
        sum = 0u; cnt = 0u; mine = 0u;
#pragma unroll
        for (unsigned j = 0; j < 16; ++j) { const unsigned c = xb_ld(&bar[XB_XCNT(j)]); sum += c; cnt += (c > 0u) ? 1u : 0u; mine = (j == x) ? c : mine; }
        if (sum == G) break;
        __builtin_amdgcn_s_sleep(1);
        if ((++sp & 255u) == 0u) { if (xb_ld(&bar[XB_TMO])) break; if (sp > XB_SPIN_CAP) { atomicAdd(&bar[XB_TMO], 1u); break; } }
    }
    nloc = mine > 0u ? mine : 1u; nx = cnt > 0u ? cnt : 1u;
}
__device__ __forceinline__ void xcd_barrier(const XcdBarrier& b) {
    asm volatile("s_waitcnt vmcnt(0)" ::: "memory");
    __syncthreads();
    if (threadIdx.x == 0) {
        unsigned* bar = b.bar;
        __builtin_amdgcn_s_waitcnt(0);
        unsigned nloc = b.st[0], nx = b.st[1];
        if (nloc == 0u) { xcd_barrier_complete(bar, b.x, nloc, nx); b.st[0] = nloc; b.st[1] = nx; }
        const unsigned old = xb_add(&bar[XB_XSUB(b.x)], 1u);
        const unsigned gen = old / nloc;
        if (old + 1u == (gen + 1u) * nloc) {
            __builtin_amdgcn_fence(__ATOMIC_RELEASE, "agent");
            asm volatile("s_waitcnt vmcnt(0)" ::: "memory");
            const unsigned og = xb_add(&bar[XB_TOP], 1u);
            const unsigned tg = og / nx;
            if (og + 1u == (tg + 1u) * nx) xb_add(&bar[XB_TOPGEN], 1u);
            else XB_SPIN(xb_ld(&bar[XB_TOPGEN]) == tg, bar);
            __builtin_amdgcn_fence(__ATOMIC_ACQUIRE, "agent");
            xb_add(&bar[XB_XGEN(b.x)], 1u);
            asm volatile("s_waitcnt vmcnt(0)" ::: "memory");
        } else {
            XB_SPIN(xb_ld(&bar[XB_XGEN(b.x)]) == gen, bar);
            __builtin_amdgcn_fence(__ATOMIC_ACQUIRE, "agent");
            asm volatile("s_waitcnt vmcnt(0)" ::: "memory");
        }
    }
    __syncthreads();
}

typedef f32x4 (&AccRef)[2][2][4][2];
struct EpiIn {
    static constexpr bool IS_IN = true;
    const float* ss; const float* cw; bf16_t* ain; float* hcv; float* hg; bf16_t* u; bf16_t* szb; unsigned char* sga; unsigned char* sgb;
    __device__ __forceinline__ void prefetch(const pg8::Unit& un, int wr, int fr, float (&pre)[8]) const {
#pragma unroll
        for (int i = 0; i < 8; ++i) pre[i] = ss[un.pm * 256 + wr * 64 + fr + (i >> 2) * 128 + (i & 3) * 16];
    }
    __device__ __forceinline__ void operator()(AccRef acc, const pg8::Unit& un, int wr, int wc, int fr, int fq, const float (&pre)[8]) const {
        const int row0 = un.pm * 256 + wr * 64 + fr;
        if (un.pn < 32) {
            const int c0 = un.pn * 64 + wc * 16 + fq * 4;
            const f32x4 w0 = *(const f32x4*)(cw + c0), w1 = *(const f32x4*)(cw + CW + c0), w2 = *(const f32x4*)(cw + 2 * CW + c0);
#pragma unroll
            for (int ai = 0; ai < 2; ++ai) {
                f32x4 cvv[4], gt[4];
#pragma unroll
                for (int m = 0; m < 4; ++m) {
                    const float rs = rsqrtf(pre[ai * 4 + m] * (1.0f / DM) + RMS_EPS);
                    const f32x4 v = acc[ai][0][m][0] * rs, bg = acc[ai][0][m][1] * rs, cgv = acc[ai][1][m][0] * rs, za = acc[ai][1][m][1] * rs;
                    cvv[m] = cgv * v; gt[m] = bg * silu4(za);
                }
                const int blk = un.pm * 4 + ai * 2 + wr;
#pragma unroll
                for (int m = 0; m < 4; ++m) {
                    const f32x4 s1 = dpp4<0x111>(cvv[m]), s2 = dpp4<0x112>(cvv[m]);
                    f32x4 p1 = s1, p2 = s2;
                    if (m > 0) { const f32x4 t1 = dpp4<0x10F>(cvv[m - 1]), t2 = dpp4<0x10E>(cvv[m - 1]);
                        if (fr < 1) p1 = t1; if (fr < 2) p2 = t2; }
                    const f32x4 o = gt[m] * (w0 * p2 + w1 * p1 + w2 * cvv[m]);
                    const size_t row = (size_t)(row0 + ai * 128 + m * 16);
                    if (m == 0) {
                        if (fr < 2) { *(f32x4*)(hg + ((size_t)blk * 2 + fr) * CW + c0) = gt[0]; *(f32x4*)(hcv + ((size_t)blk * 4 + 2 + fr) * CW + c0) = cvv[0]; }
                        else st_bf16x4(ain + row * CW + c0, o);
                    } else {
                        st_bf16x4(ain + row * CW + c0, o);
                        if (m == 3 && fr >= 14) *(f32x4*)(hcv + ((size_t)blk * 4 + (fr - 14)) * CW + c0) = cvv[3];
                    }
                }
            }
            return;
        }
#pragma unroll
        for (int ai = 0; ai < 2; ++ai)
#pragma unroll
            for (int m = 0; m < 4; ++m) {
                const int row = row0 + ai * 128 + m * 16;
                const float rs = rsqrtf(pre[ai * 4 + m] * (1.0f / DM) + RMS_EPS);
                if (un.pn < 40) {
#pragma unroll
                    for (int bj = 0; bj < 2; ++bj) {
                        const f32x4 v0 = acc[ai][bj][m][0] * rs, v1 = acc[ai][bj][m][1] * rs;
                        if (un.pn < 36) { const int cc = (un.pn - 32) * 256 + bj * 128 + wc * 32 + fq * 8;
                            st_bf16x8(u + ((size_t)((row >> 11) * SG + (cc >> 4)) * SEQ + (row & (SEQ - 1))) * SGC + (cc & 15), v0, v1); }
                        else st_bf16x8(szb + (size_t)row * SW + ((un.pn - 36) * 256 + bj * 128 + wc * 32 + fq * 8), silu4(v0), silu4(v1));
                    }
                }
                if (un.pn >= 40) {
                    unsigned char* gdst = (un.pn < 48 ? sga : sgb) + (size_t)row * DM + ((un.pn - (un.pn < 48 ? 40 : 48)) * 256 + wc * 32 + fq * 8);
#pragma unroll
                    for (int bj = 0; bj < 2; ++bj) { const f32x4 g0 = sig4(acc[ai][bj][m][0] * rs), g1 = sig4(acc[ai][bj][m][1] * rs); u32x2 w;
                        w.x = (unsigned)(g0.x * 255.f + 0.5f) | ((unsigned)(g0.y * 255.f + 0.5f) << 8) | ((unsigned)(g0.z * 255.f + 0.5f) << 16) | ((unsigned)(g0.w * 255.f + 0.5f) << 24);
                        w.y = (unsigned)(g1.x * 255.f + 0.5f) | ((unsigned)(g1.y * 255.f + 0.5f) << 8) | ((unsigned)(g1.z * 255.f + 0.5f) << 16) | ((unsigned)(g1.w * 255.f + 0.5f) << 24);
                        *(u32x2*)(gdst + bj * 128) = w; }
                }
            }
    }
};
struct EpiA {
    const bf16_t* sga; bf16_t* ma;
    __device__ __forceinline__ void prefetch(const pg8::Unit&, int, int, float (&)[8]) const {}
    __device__ __forceinline__ void operator()(AccRef acc, const pg8::Unit& un, int wr, int wc, int fr, int fq, const float (&)[8]) const { (*this)(acc, un, wr, wc, fr, fq); }
    __device__ __forceinline__ void operator()(AccRef acc, const pg8::Unit& un, int wr, int wc, int fr, int fq) const {
        const int row0 = un.pm * 256 + wr * 64 + fr, col0 = un.pn * 256 + wc * 32 + fq * 4;
#pragma unroll
        for (int ai = 0; ai < 2; ++ai)
#pragma unroll
            for (int m = 0; m < 4; ++m) {
                const size_t ro = (size_t)(row0 + ai * 128 + m * 16) * DM + col0;
#pragma unroll
                for (int bj = 0; bj < 2; ++bj)
#pragma unroll
                    for (int n = 0; n < 2; ++n) { const size_t o = ro + bj * 128 + n * 16; st_bf16x4(ma + o, acc[ai][bj][m][n] * ld_bf16x4(sga + o)); }
            }
    }
};
struct EpiMidAB {
    static constexpr bool IS_IN = false;
    const unsigned char* sga; const unsigned char* sgb;
    __device__ __forceinline__ void operator()(AccRef acc, const pg8::Unit& un, int wr, int wc, int fr, int fq) const {
        const int row0 = un.pm * 256 + wr * 64 + fr, col8 = un.pn * 256 + wc * 32 + fq * 8;
#pragma unroll
        for (int ai = 0; ai < 2; ++ai)
#pragma unroll
            for (int m = 0; m < 4; ++m) {
                const size_t ro = (size_t)(row0 + ai * 128 + m * 16) * DM + col8;
#pragma unroll
                for (int bj = 0; bj < 2; ++bj) { const u32x2 wa2 = *(const u32x2*)(sga + ro + bj * 128), wb2 = *(const u32x2*)(sgb + ro + bj * 128);
#pragma unroll
                    for (int n = 0; n < 2; ++n) { const unsigned wa = n ? wa2.y : wa2.x, wb = n ? wb2.y : wb2.x; f32x4 r;
                        r.x = (float)(wa & 255u) * __builtin_amdgcn_rcpf(fmaxf((float)(wb & 255u), 0.25f)); r.y = (float)((wa >> 8) & 255u) * __builtin_amdgcn_rcpf(fmaxf((float)((wb >> 8) & 255u), 0.25f));
                        r.z = (float)((wa >> 16) & 255u) * __builtin_amdgcn_rcpf(fmaxf((float)((wb >> 16) & 255u), 0.25f)); r.w = (float)(wa >> 24) * __builtin_amdgcn_rcpf(fmaxf((float)(wb >> 24), 0.25f));
                        acc[ai][bj][m][n] = acc[ai][bj][m][n] * r; } }
            }
    }
};
struct EpiFinAB {
    static constexpr bool IS_IN = false;
    const unsigned char* sgb; bf16_t* mo;
    __device__ __forceinline__ void operator()(AccRef acc, const pg8::Unit& un, int wr, int wc, int fr, int fq) const {
        const int row0 = un.pm * 256 + wr * 64 + fr, col8 = un.pn * 256 + wc * 32 + fq * 8;
        const rsrc_t r_m = mk_rsrc(mo);
        const float k = 1.0f / 255.0f;
#pragma unroll
        for (int ai = 0; ai < 2; ++ai)
#pragma unroll
            for (int m = 0; m < 4; ++m) {
                const size_t ro = (size_t)(row0 + ai * 128 + m * 16) * DM + col8;
#pragma unroll
                for (int bj = 0; bj < 2; ++bj) { const u32x2 wb2 = *(const u32x2*)(sgb + ro + bj * 128); f32x4 g[2];
#pragma unroll
                    for (int n = 0; n < 2; ++n) { const unsigned wb = n ? wb2.y : wb2.x;
                        g[n].x = fmaxf((float)(wb & 255u), 0.25f) * k; g[n].y = fmaxf((float)((wb >> 8) & 255u), 0.25f) * k; g[n].z = fmaxf((float)((wb >> 16) & 255u), 0.25f) * k; g[n].w = fmaxf((float)(wb >> 24), 0.25f) * k; }
                    wt_bf16x8(r_m, ro + bj * 128, acc[ai][bj][m][0] * g[0], acc[ai][bj][m][1] * g[1]); }
            }
    }
};
template <int NAI> struct EpiGluT {
    static constexpr bool IS_IN = false;
    const bf16_t* gi; const bf16_t* szb; const float* bglu; bf16_t* bin;
    __device__ __forceinline__ void prefetch(const pg8::Unit&, int, int, float (&)[8]) const {}
    __device__ __forceinline__ void operator()(AccRef acc, const pg8::Unit& un, int wr, int wc, int fr, int fq, const float (&)[8]) const { (*this)(acc, un, wr, wc, fr, fq); }
    __device__ __forceinline__ void operator()(AccRef acc, const pg8::Unit& un, int wr, int wc, int fr, int fq) const {
        const int row0 = un.pm * (128 * NAI) + wr * 64 + fr, col8 = un.pn * 256 + wc * 32 + fq * 8;
        const rsrc_t r_bin = mk_rsrc(bin);
        f32x4 bv[2][2];
#pragma unroll
        for (int bj = 0; bj < 2; ++bj)
#pragma unroll
            for (int n = 0; n < 2; ++n) bv[bj][n] = *(const f32x4*)(bglu + col8 + bj * 128 + n * 4);
#pragma unroll
        for (int ai = 0; ai < NAI; ++ai)
#pragma unroll
            for (int m = 0; m < 4; ++m) {
                const int row = row0 + ai * 128 + m * 16;
#pragma unroll
                for (int bj = 0; bj < 2; ++bj) { const int col = col8 + bj * 128; const size_t o = (size_t)row * SW + col;
                    const size_t og = ((size_t)((row >> 11) * SG + (col >> 4)) * SEQ + (row & (SEQ - 1))) * SGC + (col & 15);
                    const F8 gv = ld_bf16x8(gi + og), zv = ld_bf16x8(szb + o);
                    wt_bf16x8(r_bin, o, gv.lo * sig4(acc[ai][bj][m][0] + bv[bj][0]) * zv.lo, gv.hi * sig4(acc[ai][bj][m][1] + bv[bj][1]) * zv.hi); }
            }
    }
};
typedef EpiGluT<2> EpiGlu;
struct EpiB {
    const bf16_t* ma; const bf16_t* sgb; bf16_t* mo;
    __device__ __forceinline__ void prefetch(const pg8::Unit&, int, int, float (&)[8]) const {}
    __device__ __forceinline__ void operator()(AccRef acc, const pg8::Unit& un, int wr, int wc, int fr, int fq, const float (&)[8]) const { (*this)(acc, un, wr, wc, fr, fq); }
    __device__ __forceinline__ void operator()(AccRef acc, const pg8::Unit& un, int wr, int wc, int fr, int fq) const {
        const int row0 = un.pm * 256 + wr * 64 + fr, col0 = un.pn * 256 + wc * 32 + fq * 4;
#pragma unroll
        for (int ai = 0; ai < 2; ++ai)
#pragma unroll
            for (int m = 0; m < 4; ++m) {
                const size_t ro = (size_t)(row0 + ai * 128 + m * 16) * DM + col0;
#pragma unroll
                for (int bj = 0; bj < 2; ++bj)
#pragma unroll
                    for (int n = 0; n < 2; ++n) { const size_t o = ro + bj * 128 + n * 16; st_bf16x4(mo + o, ld_bf16x4(ma + o) + acc[ai][bj][m][n] * ld_bf16x4(sgb + o)); }
            }
    }
};
struct EpiO {
    const float* xin; float* xo; bf16_t* xb; float* ssn; bf16_t* xlo;
    __device__ __forceinline__ void prefetch(const pg8::Unit&, int, int, float (&)[8]) const {}
    __device__ __forceinline__ void operator()(AccRef acc, const pg8::Unit& un, int wr, int wc, int fr, int fq, const float (&)[8]) const { (*this)(acc, un, wr, wc, fr, fq); }
    __device__ __forceinline__ void operator()(AccRef acc, const pg8::Unit& un, int wr, int wc, int fr, int fq) const {
        const int row0 = un.pm * 256 + wr * 64 + fr, col8 = un.pn * 256 + wc * 32 + fq * 8;
#pragma unroll
        for (int ai = 0; ai < 2; ++ai)
#pragma unroll
            for (int m = 0; m < 4; ++m) {
                const int row = row0 + ai * 128 + m * 16;
                const size_t ro = (size_t)row * DM + col8; float s = 0.f;
#pragma unroll
                for (int bj = 0; bj < 2; ++bj) { const size_t o = ro + bj * 128;
                    const f32x4 v0 = *(const f32x4*)(xin + o) + acc[ai][bj][m][0], v1 = *(const f32x4*)(xin + o + 4) + acc[ai][bj][m][1];
                    if (xlo) wt_bf16x8(mk_rsrc(xb), o, v0, v1);
                    else { *(f32x4*)(xo + o) = v0; *(f32x4*)(xo + o + 4) = v1; if (xb) st_bf16x8(xb + o, v0, v1); }
                    s += ((v0.x * v0.x + v0.y * v0.y) + (v0.z * v0.z + v0.w * v0.w)) + ((v1.x * v1.x + v1.y * v1.y) + (v1.z * v1.z + v1.w * v1.w)); }
                s += __shfl_xor(s, 16); s += __shfl_xor(s, 32);
                if (fq == 0 && ssn) atomicAdd(ssn + row, s);
            }
    }
};

struct EpiOFin {
    static constexpr bool IS_IN = false;
    const float* xin; float* out; float* ssn; const float* fg; XcdBarrier xb; const bf16_t* xhi; const bf16_t* xlo;
    __device__ __forceinline__ void prefetch(const pg8::Unit&, int, int, float (&)[8]) const {}
    __device__ __forceinline__ void operator()(AccRef acc, const pg8::Unit& un, int wr, int wc, int fr, int fq, const float (&)[8]) const { (*this)(acc, un, wr, wc, fr, fq); }
    __device__ __forceinline__ void operator()(AccRef acc, const pg8::Unit& un, int wr, int wc, int fr, int fq) const {
        const int row0 = un.pm * 256 + wr * 64 + fr, col8 = un.pn * 256 + wc * 32 + fq * 8;
#pragma unroll
        for (int ai = 0; ai < 2; ++ai)
#pragma unroll
            for (int m = 0; m < 4; ++m) {
                const int row = row0 + ai * 128 + m * 16;
                const size_t ro = (size_t)row * DM + col8; float s = 0.f;
#pragma unroll
                for (int bj = 0; bj < 2; ++bj) { const size_t o = ro + bj * 128; f32x4 x0, x1;
                    if (xhi) { const F8 h = ld_bf16x8(xhi + o); x0 = h.lo; x1 = h.hi; } else { x0 = *(const f32x4*)(xin + o); x1 = *(const f32x4*)(xin + o + 4); }
                    const f32x4 v0 = x0 + acc[ai][bj][m][0], v1 = x1 + acc[ai][bj][m][1]; acc[ai][bj][m][0] = v0; acc[ai][bj][m][1] = v1;
                    s += ((v0.x * v0.x + v0.y * v0.y) + (v0.z * v0.z + v0.w * v0.w)) + ((v1.x * v1.x + v1.y * v1.y) + (v1.z * v1.z + v1.w * v1.w)); }
                s += __shfl_xor(s, 16); s += __shfl_xor(s, 32);
                if (fq == 0) atomicAdd(ssn + row, s);
            }
        f32x4 gv[2][2];
#pragma unroll
        for (int bj = 0; bj < 2; ++bj)
#pragma unroll
            for (int n = 0; n < 2; ++n) gv[bj][n] = *(const f32x4*)(fg + col8 + bj * 128 + n * 4);
        xcd_barrier(xb);
#pragma unroll
        for (int ai = 0; ai < 2; ++ai)
#pragma unroll
            for (int m = 0; m < 4; ++m) {
                const int row = row0 + ai * 128 + m * 16;
                const float rs = rsqrtf(__hip_atomic_load(ssn + row, __ATOMIC_RELAXED, __HIP_MEMORY_SCOPE_AGENT) * (1.0f / DM) + RMS_EPS);
                const size_t ro = (size_t)row * DM + col8;
#pragma unroll
                for (int bj = 0; bj < 2; ++bj)
#pragma unroll
                    for (int n = 0; n < 2; ++n) *(f32x4*)(out + ro + bj * 128 + n * 4) = acc[ai][bj][m][n] * rs * gv[bj][n];
            }
    }
};

struct Args { const float* in[18]; float* out; unsigned char* ws; int lo, hi, coop, pad; };

__device__ __forceinline__ int perm_col(int np) { const int tc = np & 31; return (np & ~31) | (((tc >> 2) & 3) << 3) | (((tc >> 4) & 1) << 2) | (tc & 3); }
__device__ __forceinline__ int win_src_col(int np) {
    if (np >= 8192) return perm_col(np);
    const int tile = np >> 8, tc = np & 255, bj = tc >> 7, wc = (tc >> 5) & 3, n = (tc >> 4) & 1, lo = tc & 15;
    return (2 * bj + n) * 2048 + 64 * tile + 16 * wc + lo;
}
struct TrItem { const float* W; bf16_t* WT; const float* ksc; int K, N, k0, n0, perm; };
__device__ __forceinline__ TrItem tr_decode(const Args& a, int it) {
    constexpr int I_IN = (DM / 64) * (NIN / 32), I_A = (CW / 64) * (DM / 32), I_G = (SW / 64) * (SW / 32), I_B = (SW / 64) * (DM / 32), I_O = (DM / 64) * (DM / 32);
    constexpr int I_L = I_IN + I_A + I_G + I_B + I_O;
    unsigned char* ws = a.ws; TrItem t; const int l = it / I_L; int r = it % I_L; t.ksc = nullptr; t.perm = 0;
    if (r < I_IN) { t.W = a.in[2] + (size_t)l * DM * NIN; t.WT = (bf16_t*)(ws + WS_WIN) + (size_t)l * NIN * DM; t.K = DM; t.N = NIN; t.ksc = a.in[1] + l * DM; t.perm = 1; }
    else if ((r -= I_IN) < I_A) { t.W = a.in[4] + (size_t)l * CW * DM; t.WT = (bf16_t*)(ws + WS_WA) + (size_t)l * DM * CW; t.K = CW; t.N = DM; }
    else if ((r -= I_A) < I_G) { t.W = a.in[13] + (size_t)l * SW * SW; t.WT = (bf16_t*)(ws + WS_WGLU) + (size_t)l * SW * SW; t.K = SW; t.N = SW; }
    else if ((r -= I_G) < I_B) { t.W = a.in[15] + (size_t)l * SW * DM; t.WT = (bf16_t*)(ws + WS_WB) + (size_t)l * DM * SW; t.K = SW; t.N = DM; }
    else { r -= I_B; t.W = a.in[16] + (size_t)l * DM * DM; t.WT = (bf16_t*)(ws + WS_WO) + (size_t)l * DM * DM; t.K = DM; t.N = DM; }
    const int nblk = t.N / 32; t.k0 = 64 * (r / nblk); t.n0 = 32 * (r % nblk);
    return t;
}
__device__ __forceinline__ void tr_load(const TrItem& t, int lane, f32x4 (&v)[8]) {
    const int kq = lane >> 3, np = t.n0 + 4 * (lane & 7), sc = t.perm ? win_src_col(np) : perm_col(np);
    const float* p = t.W + (size_t)(t.k0 + kq) * t.N + sc;
#pragma unroll
    for (int i = 0; i < 8; ++i) v[i] = *(const f32x4*)(p + (size_t)(8 * i) * t.N);
}
__device__ __forceinline__ void tr_store(const TrItem& t, int lane, f32x4 (&v)[8], LAS float* scr) {
    const int kq = lane >> 3, n4 = lane & 7;
#pragma unroll
    for (int i = 0; i < 8; ++i) { const int kk = 8 * i + kq; const float sc = t.ksc ? t.ksc[t.k0 + kk] : 1.0f; LAS float* d = scr + kk * 33 + 4 * n4;
        d[0] = v[i].x * sc; d[1] = v[i].y * sc; d[2] = v[i].z * sc; d[3] = v[i].w * sc; }
    LDS_WAIT();
    const int c = lane & 7;
#pragma unroll
    for (int j = 0; j < 4; ++j) { const int n = (lane >> 3) + 8 * j; const LAS float* s = scr + (8 * c) * 33 + n;
        u32x4 o; o.x = cvt_pk_bf16(s[0 * 33], s[1 * 33]); o.y = cvt_pk_bf16(s[2 * 33], s[3 * 33]); o.z = cvt_pk_bf16(s[4 * 33], s[5 * 33]); o.w = cvt_pk_bf16(s[6 * 33], s[7 * 33]);
        *(u32x4*)(t.WT + (size_t)(t.n0 + n) * t.K + t.k0 + 8 * c) = o; }
    LDS_WAIT();
}

__device__ __forceinline__ void ssm_coef(const Args& a, int idx, float& lre, float& lim, float& cre, float& cim) {
    const float are = a.in[5][idx], aim = a.in[6][idx], dt = expf(a.in[7][idx / SP]);
    const float e = expf(are * dt); float sn, cs; sincosf(aim * dt, &sn, &cs);
    lre = e * cs; lim = e * sn;
    const float nre = lre - 1.f, nim = lim, den = 1.0f / (are * are + aim * aim);
    cre = (nre * are + nim * aim) * den; cim = (nim * are - nre * aim) * den;
}
__device__ __forceinline__ void phase_prologue(const Args& a, LAS unsigned char* lds, int gw, int NGW, int wave, int lane) {
    unsigned char* ws = a.ws;
    LAS float* scr = (LAS float*)(lds + wave * 16384);
    constexpr int I_TOT = DEPTH * ((DM / 64) * (NIN / 32) + (CW / 64) * (DM / 32) + (SW / 64) * (SW / 32) + (SW / 64) * (DM / 32) + (DM / 64) * (DM / 32));
    {
        TrItem ta = tr_decode(a, gw), tb = ta; f32x4 va[8], vb[8];
        bool hb = (gw + NGW) < I_TOT;
        tr_load(ta, lane, va);
        if (hb) { tb = tr_decode(a, gw + NGW); tr_load(tb, lane, vb); }
        for (int it = gw; it < I_TOT; it += 2 * NGW) {
            const int nit = it + 2 * NGW; const bool na = nit < I_TOT, nb = (nit + NGW) < I_TOT;
            TrItem tc = ta, td = tb; f32x4 vc[8], vd[8];
#pragma unroll
            for (int i = 0; i < 8; ++i) { vc[i] = (f32x4){0.f, 0.f, 0.f, 0.f}; vd[i] = vc[i]; }
            if (na) { tc = tr_decode(a, nit); tr_load(tc, lane, vc); }
            if (nb) { td = tr_decode(a, nit + NGW); tr_load(td, lane, vd); }
            tr_store(ta, lane, va, scr); if (hb) tr_store(tb, lane, vb, scr);
            ta = tc; tb = td; hb = nb;
#pragma unroll
            for (int i = 0; i < 8; ++i) { va[i] = vc[i]; vb[i] = vd[i]; }
        }
    }
    float* ss = (float*)(ws + WS_SS);
    for (int row = gw; row < MTOK; row += NGW) {
        const f32x4* xr = (const f32x4*)(a.in[0] + (size_t)row * DM) + lane; float s = 0.f;
        u32x2* o = (u32x2*)((bf16_t*)(ws + WS_XB) + (size_t)row * DM) + lane;
#pragma unroll
        for (int j = 0; j < 8; ++j) { const f32x4 v = xr[64 * j]; s += (v.x * v.x + v.y * v.y) + (v.z * v.z + v.w * v.w); u32x2 w; w.x = cvt_pk_bf16(v.x, v.y); w.y = cvt_pk_bf16(v.z, v.w); o[64 * j] = w; }
        s = wave_sum(s);
        if (lane == 0) { ss[row] = s; ss[MTOK + row] = 0.f; ss[2 * MTOK + row] = 0.f; }
    }
    const int gt = gw * 64 + lane;
    if (gt < DEPTH * SG * SP) {
        float lre, lim, cre, cim; ssm_coef(a, gt, lre, lim, cre, cim);
        ((f32x2*)(ws + WS_LAMB))[gt] = (f32x2){lre, lim};
        float tre = lre, tim = lim;
#pragma unroll
        for (int k = 0; k < 8; ++k) { const float nr = tre * tre - tim * tim, ni = 2.f * tre * tim; tre = nr; tim = ni; }
        ((f32x2*)(ws + WS_LAMT))[gt] = (f32x2){tre, tim};
    }
    if (gt < DEPTH * SG * 8 * 64) {
        const int ln = gt & 63, nt = (gt >> 6) & 7, lg = gt >> 9, fr = ln & 15, fq = ln >> 4, p = 8 * nt + (fr >> 1), ri = fr & 1;
        float lre, lim, cre, cim; ssm_coef(a, lg * SP + p, lre, lim, cre, cim);
        float v[8];
#pragma unroll
        for (int j = 0; j < 8; ++j) { const int c = (8 * fq + j) & 15; const float br = a.in[8][((size_t)lg * SP + p) * SGC + c], bi = a.in[9][((size_t)lg * SP + p) * SGC + c];
            v[j] = ri ? (cre * bi + cim * br) : (cre * br - cim * bi); }
        u32x4 o; o.x = cvt_pk_bf16(v[0], v[1]); o.y = cvt_pk_bf16(v[2], v[3]); o.z = cvt_pk_bf16(v[4], v[5]); o.w = cvt_pk_bf16(v[6], v[7]);
        ((u32x4*)(ws + WS_BF))[gt] = o;
    }
    if (gt < DEPTH * SG * 4 * 64) {
        const int ln = gt & 63, kk = (gt >> 6) & 3, lg = gt >> 8, fr = ln & 15, fq = ln >> 4;
        float v[8];
#pragma unroll
        for (int j = 0; j < 8; ++j) { const int p = 16 * kk + 4 * fq + (j >> 1); const size_t ci = ((size_t)lg * SGC + fr) * SP + p; v[j] = (j & 1) ? -a.in[11][ci] : a.in[10][ci]; }
        u32x4 o; o.x = cvt_pk_bf16(v[0], v[1]); o.y = cvt_pk_bf16(v[2], v[3]); o.z = cvt_pk_bf16(v[4], v[5]); o.w = cvt_pk_bf16(v[6], v[7]);
        ((u32x4*)(ws + WS_CF))[gt] = o;
    }
}

__device__ __forceinline__ void phase_convfix(const Args& a, int l, int gtid, int ngt) {
    unsigned char* ws = a.ws;
    const float* hcv = (const float*)(ws + WS_CV); const float* hg = (const float*)(ws + WS_GATE); bf16_t* ain = (bf16_t*)(ws + WS_AIN);
    const float* cw = a.in[3] + (size_t)l * 3 * CW;
    for (int idx = gtid; idx < (MTOK / 64) * 2 * (CW / 4); idx += ngt) {
        const int c4 = (idx & (CW / 4 - 1)) * 4, rr = (idx / (CW / 4)) & 1, blk = idx / (2 * (CW / 4));
        const int row = blk * 64 + rr, t = row & (SEQ - 1);
        const f32x4 z = (f32x4){0.f, 0.f, 0.f, 0.f};
        const f32x4 x0 = *(const f32x4*)(hcv + ((size_t)blk * 4 + 2 + rr) * CW + c4);
        f32x4 x1, x2;
        if (rr == 1) { x1 = *(const f32x4*)(hcv + ((size_t)blk * 4 + 2) * CW + c4); x2 = (t >= 2) ? *(const f32x4*)(hcv + ((size_t)(blk - 1) * 4 + 1) * CW + c4) : z; }
        else { x1 = (t >= 1) ? *(const f32x4*)(hcv + ((size_t)(blk - 1) * 4 + 1) * CW + c4) : z; x2 = (t >= 2) ? *(const f32x4*)(hcv + ((size_t)(blk - 1) * 4 + 0) * CW + c4) : z; }
        const f32x4 g = *(const f32x4*)(hg + ((size_t)blk * 2 + rr) * CW + c4);
        const f32x4 w0 = *(const f32x4*)(cw + c4), w1 = *(const f32x4*)(cw + CW + c4), w2 = *(const f32x4*)(cw + 2 * CW + c4);
        st_bf16x4(ain + (size_t)row * CW + c4, g * (w0 * x2 + w1 * x1 + w2 * x0));
    }
}

constexpr int SC_BU_ROW = 272, SC_HB_ROW = 272, SC_WAVE_BYTES = 16 * SC_BU_ROW + 16 * SC_HB_ROW;
template <int PASS, bool LDSX>
__device__ __forceinline__ void phase_scan(const Args& a, int l, LAS unsigned char* lds, int gw, int NGW, int wave, int lane) {
    unsigned char* ws = a.ws;
    const bf16_t* ubase = (const bf16_t*)(ws + WS_U) + (size_t)l * MTOK * SW;
    f32x2* st = (f32x2*)(ws + WS_ST);
    LAS unsigned char* bu = lds + wave * SC_WAVE_BYTES;
    LAS unsigned char* hb = bu + 16 * SC_BU_ROW;
    LAS f32x2* sx = (LAS f32x2*)(lds + NWAVES * SC_WAVE_BYTES);
    const int fr = lane & 15, fq = lane >> 4;
    for (int item = gw; item < NB * SG * NCHUNK; item += NGW) {
        const int j = item & (NCHUNK - 1), bg = item / NCHUNK, g = bg & (SG - 1), b = bg / SG;
        const int lg = l * SG + g;
        const f32x2 lam = ((const f32x2*)(ws + WS_LAMB))[lg * SP + lane];
        const float nlamy = -lam.y;
        bf16x8 bfr[8];
        { const bf16x8* bfp = (const bf16x8*)(ws + WS_BF) + (size_t)lg * 8 * 64 + lane;
#pragma unroll
          for (int nt = 0; nt < 8; ++nt) bfr[nt] = bfp[nt * 64]; }
        bf16x8 cfr[4]; f32x4 dsk = (f32x4){0.f, 0.f, 0.f, 0.f};
        if (PASS == 2) { const bf16x8* cfp = (const bf16x8*)(ws + WS_CF) + (size_t)lg * 4 * 64 + lane;
#pragma unroll
          for (int kk = 0; kk < 4; ++kk) cfr[kk] = cfp[kk * 64];
          dsk = *(const f32x4*)(a.in[12] + lg * SGC + 4 * fq); }
        const int rowbase = b * SEQ + j * CHUNK;
        const bf16_t* ui = ubase + ((size_t)(b * SG + g) * SEQ + j * CHUNK) * SGC;
        const bf16_t* up = ui + fr * SGC + (fq & 1) * 8;
        const bf16_t* uq = ui + fr * SGC + 4 * fq;
        const size_t oo = (size_t)(rowbase + fr) * SW + g * SGC + 4 * fq;
        const u32x4 zz = (u32x4){0u, 0u, 0u, 0u};
        u32x4 cua[4]; u32x2 cuv[4];
#pragma unroll
        for (int q = 0; q < 4; ++q) { cua[q] = (fq < 2) ? *(const u32x4*)(up + (size_t)q * 16 * SGC) : zz; cuv[q] = (u32x2){0u, 0u}; if (PASS == 2) cuv[q] = *(const u32x2*)(uq + (size_t)q * 16 * SGC); }
        float hre = 0.f, him = 0.f;
        if (PASS == 2) {
            const f32x2 lt = ((const f32x2*)(ws + WS_LAMT))[lg * SP + lane];
            f32x2 sv[NCHUNK - 1];
#pragma unroll
            for (int i = 0; i < NCHUNK - 1; ++i) sv[i] = (i < j) ? (LDSX ? sx[i * SP + lane] : st[(size_t)(item - j + i) * SP + lane]) : (f32x2){0.f, 0.f};
#pragma unroll
            for (int i = 0; i < NCHUNK - 1; ++i) if (i < j) { const float nr = lt.x * hre - lt.y * him + sv[i].x, ni = lt.x * him + lt.y * hre + sv[i].y; hre = nr; him = ni; }
        }
#pragma unroll 1
        for (int grp = 0; grp < CHUNK / 64; ++grp) {
            const int ngrp = (grp + 1 < CHUNK / 64) ? grp + 1 : grp;
            u32x4 nua[4]; u32x2 nuv[4];
#pragma unroll
            for (int q = 0; q < 4; ++q) { nua[q] = (fq < 2) ? *(const u32x4*)(up + (size_t)(ngrp * 4 + q) * 16 * SGC) : zz; nuv[q] = (u32x2){0u, 0u}; if (PASS == 2) nuv[q] = *(const u32x2*)(uq + (size_t)(ngrp * 4 + q) * 16 * SGC); }
#pragma unroll
            for (int q = 0; q < 4; ++q) {
                const int sub = grp * 4 + q;
                const bf16x8 uf = __builtin_bit_cast(bf16x8, cua[q]);
                f32x4 dd[8];
#pragma unroll
                for (int nt = 0; nt < 8; ++nt) dd[nt] = __builtin_amdgcn_mfma_f32_16x16x32_bf16(bfr[nt], uf, (f32x4){0.f, 0.f, 0.f, 0.f}, 0, 0, 0);
                __builtin_amdgcn_sched_barrier(0);
#pragma unroll
                for (int nt = 0; nt < 8; ++nt) {
                    u32x2 dp; dp.x = cvt_pk_bf16(dd[nt].x, dd[nt].y); dp.y = cvt_pk_bf16(dd[nt].z, dd[nt].w);
                    *(LAS u32x2*)(bu + fr * SC_BU_ROW + (8 * nt + 2 * fq) * 4) = dp;
                }
                LDS_WAIT();
                unsigned vbr[16];
#pragma unroll
                for (int s = 0; s < 16; ++s) vbr[s] = *(const LAS unsigned*)(bu + s * SC_BU_ROW + lane * 4);
                LDS_WAIT();
#pragma unroll
                for (int s = 0; s < 16; ++s) {
                    const f32x2 v = (f32x2){__uint_as_float(vbr[s] << 16), __uint_as_float(vbr[s] & 0xffff0000u)};
                    const float tr = __builtin_fmaf(nlamy, him, v.x), ti = __builtin_fmaf(lam.y, hre, v.y);
                    hre = __builtin_fmaf(lam.x, hre, tr); him = __builtin_fmaf(lam.x, him, ti);
                    if (PASS == 2) *(LAS unsigned*)(hb + s * SC_HB_ROW + lane * 4) = cvt_pk_bf16(hre, him);
                }
                if (PASS == 2) {
                    LDS_WAIT();
                    f32x4 y = (f32x4){0.f, 0.f, 0.f, 0.f};
#pragma unroll
                    for (int kk = 0; kk < 4; ++kk) { const bf16x8 hf = *(const LAS bf16x8*)(hb + fr * SC_HB_ROW + (32 * kk + 8 * fq) * 2); y = __builtin_amdgcn_mfma_f32_16x16x32_bf16(cfr[kk], hf, y, 0, 0, 0); }
                    const u32x2 uv = cuv[q];
                    const f32x4 uf4 = (f32x4){__uint_as_float(uv.x << 16), __uint_as_float(uv.x & 0xffff0000u), __uint_as_float(uv.y << 16), __uint_as_float(uv.y & 0xffff0000u)};
                    f32x4 ge; ge.x = geluf_(y.x + dsk.x * uf4.x); ge.y = geluf_(y.y + dsk.y * uf4.y); ge.z = geluf_(y.z + dsk.z * uf4.z); ge.w = geluf_(y.w + dsk.w * uf4.w);
                    st_bf16x4((bf16_t*)(ws + WS_GLUIN) + ((size_t)(b * SG + g) * SEQ + j * CHUNK + sub * 16 + fr) * SGC + 4 * fq, ge);
                }
                LDS_WAIT();
            }
#pragma unroll
            for (int q = 0; q < 4; ++q) { cua[q] = nua[q]; cuv[q] = nuv[q]; }
        }
        if (PASS == 1) { if (LDSX) sx[j * SP + lane] = (f32x2){hre, him}; else st[(size_t)item * SP + lane] = (f32x2){hre, him}; }
    }
}

__device__ __forceinline__ void phase_final(const Args& a, int gw, int NGW, int lane) {
    const float* ss = (const float*)(a.ws + WS_SS) + 2 * MTOK;
    const f32x4* gp = (const f32x4*)a.in[17] + lane;
    for (int row = gw; row < MTOK; row += NGW) {
        const float rs = rsqrtf(ss[row] * (1.0f / DM) + RMS_EPS);
        f32x4* xr = (f32x4*)(a.out + (size_t)row * DM) + lane;
#pragma unroll
        for (int j = 0; j < 8; ++j) xr[64 * j] = xr[64 * j] * rs * gp[64 * j];
    }
}

__global__ void __launch_bounds__(NTHREADS, 2) fwd_kernel(Args a) {
    extern __shared__ __attribute__((aligned(16))) unsigned char lds_raw[];
    LAS unsigned char* lds = (LAS unsigned char*)lds_raw;
    cg::grid_group grid = cg::this_grid();
    const int tid = threadIdx.x, lane = tid & 63, wave = __builtin_amdgcn_readfirstlane(tid >> 6);
    const int G = gridDim.x, gw = blockIdx.x * NWAVES + wave, NGW = G * NWAVES;
    unsigned char* ws = a.ws;
    const int lo = a.lo, hi = a.hi;
#define IN(k) (lo <= (k) && (k) < hi)
#if MK_XCDBAR
    volatile LAS unsigned* bst = (volatile LAS unsigned*)(lds + LDS_STAGE);
    if (tid < 4) bst[tid] = 0u;
    __syncthreads();
    XcdBarrier xbar = xcd_barrier_post((unsigned*)(ws + WS_CTL), bst);
#define SEAM(k) do { if (a.coop && IN(k) && IN((k) + 1)) { if (a.coop == 2) grid.sync(); else xcd_barrier(xbar); } } while (0)
#else
#define SEAM(k) do { if (a.coop && IN(k) && IN((k) + 1)) grid.sync(); } while (0)
#endif
#ifndef PROBE_REP
#define PROBE_REP -1
#endif
#define REPS(k) for (int rep = 0; rep < ((PROBE_REP == (k)) ? 2 : 1); ++rep)

    const bool fuse_final = MK_XCDBAR && a.coop && G == 256 && lo == 0 && hi == 14 && PROBE_REP != 6;
    if (IN(0)) REPS(0) { phase_prologue(a, lds, gw, NGW, wave, lane); }
    SEAM(0);
    for (int l = 0; l < DEPTH; ++l) {
        const int pb = 1 + 6 * l;
        float* ss = (float*)(ws + WS_SS);
        if (IN(pb + 0)) REPS(1) {
            pg8::Gemm g{(const bf16_t*)(ws + WS_XB), (const bf16_t*)(ws + WS_WIN) + (size_t)l * NIN * DM, MTOK, NIN, DM};
            pg8::StaticOrder S; S.init(MTOK, NIN, G, (int)blockIdx.x);
            EpiIn E{ss + (size_t)l * MTOK, a.in[3] + (size_t)l * 3 * CW, (bf16_t*)(ws + WS_AIN), (float*)(ws + WS_CV), (float*)(ws + WS_GATE), (bf16_t*)(ws + WS_U) + (size_t)l * MTOK * SW, (bf16_t*)(ws + WS_SZB), (unsigned char*)(ws + WS_SGA), (unsigned char*)(ws + WS_SGB)};
            pg8::gemm_phase<EpiIn>(lds, g, S, E);
        }
        SEAM(pb + 0);
        const bool scan_merged = a.coop && IN(pb + 1) && IN(pb + 2) && NGW == NB * SG * NCHUNK && NWAVES == NCHUNK && PROBE_REP != 2 && PROBE_REP != 3;
        if (IN(pb + 1)) REPS(2) {
            int tl = tid; asm volatile("" : "+v"(tl));
            phase_convfix(a, l, blockIdx.x * NTHREADS + tl, G * NTHREADS);
            if (scan_merged) phase_scan<1, true>(a, l, lds, gw, NGW, wave, tl & 63); else phase_scan<1, false>(a, l, lds, gw, NGW, wave, tl & 63);
        }
        if (scan_merged) { LDS_WAIT(); __syncthreads(); } else SEAM(pb + 1);
        if (IN(pb + 2)) REPS(3) {
            int tl = tid; asm volatile("" : "+v"(tl));
            if (scan_merged) phase_scan<2, true>(a, l, lds, gw, NGW, wave, tl & 63); else phase_scan<2, false>(a, l, lds, gw, NGW, wave, tl & 63);
        }
        SEAM(pb + 2);
        if (IN(pb + 3)) REPS(4) {
            pg8::Gemm g{(const bf16_t*)(ws + WS_GLUIN), (const bf16_t*)(ws + WS_WGLU) + (size_t)l * SW * SW, MTOK, SW, SW};
            EpiGluT<1> E{(const bf16_t*)(ws + WS_GLUIN), (const bf16_t*)(ws + WS_SZB), a.in[14] + l * SW, (bf16_t*)(ws + WS_BIN)};
            pg8::gemm_mhalf<EpiGluT<1>>(lds, g, G, (int)blockIdx.x, E);
        }
        SEAM(pb + 3);
        if (IN(pb + 4)) REPS(5) {
            pg8::Gemm ga{(const bf16_t*)(ws + WS_AIN), (const bf16_t*)(ws + WS_WA) + (size_t)l * DM * CW, MTOK, DM, CW};
            pg8::Gemm gb{(const bf16_t*)(ws + WS_BIN), (const bf16_t*)(ws + WS_WB) + (size_t)l * DM * SW, MTOK, DM, SW};
            pg8::StaticOrder S; S.init(MTOK, DM, G, (int)blockIdx.x);
            EpiMidAB Em{(const unsigned char*)(ws + WS_SGA), (const unsigned char*)(ws + WS_SGB)};
            EpiFinAB Ef{(const unsigned char*)(ws + WS_SGB), (bf16_t*)(ws + WS_M)};
            pg8::gemm_chain2<EpiMidAB, EpiFinAB>(lds, ga, gb, S, Em, Ef);
        }
        SEAM(pb + 4);
        if (IN(pb + 5)) REPS(6) {
            pg8::Gemm g{(const bf16_t*)(ws + WS_M), (const bf16_t*)(ws + WS_WO) + (size_t)l * DM * DM, MTOK, DM, DM};
            pg8::StaticOrder S; S.init(MTOK, DM, G, (int)blockIdx.x);
            if (l == DEPTH - 1 && fuse_final) {
                EpiOFin E{(const float*)(ws + WS_X1), a.out, ss + (size_t)(l + 1) * MTOK, a.in[17], xbar, (const bf16_t*)(ws + WS_XB), (const bf16_t*)(ws + WS_X1)};
                pg8::gemm_phase<EpiOFin>(lds, g, S, E);
            } else {
                EpiO E{l == 0 ? a.in[0] : (const float*)(ws + WS_X1), l == 0 ? (float*)(ws + WS_X1) : a.out, l == 0 ? (bf16_t*)(ws + WS_XB) : (bf16_t*)nullptr, rep == 0 ? ss + (size_t)(l + 1) * MTOK : (float*)nullptr, (l == 0 && fuse_final) ? (bf16_t*)(ws + WS_X1) : (bf16_t*)nullptr};
                pg8::gemm_phase<EpiO>(lds, g, S, E);
            }
        }
        if (!(l == DEPTH - 1 && fuse_final)) SEAM(pb + 5);
    }
    if (IN(13) && !fuse_final) phase_final(a, gw, NGW, lane);
#undef IN
#undef SEAM
}

extern "C" void kernel_launch(void* const* d_in, const int* in_sizes, int n_in, void* d_out, int out_size, void* d_ws, size_t ws_size, hipStream_t stream) {
    static int grid = 0;
    if (grid == 0) {
        if (n_in != 18 || ws_size < WS_END) { fprintf(stderr, "kernel_launch: unexpected n_in %d or ws %zu < %zu\n", n_in, ws_size, (size_t)WS_END); grid = -1; return; }
        int dev = 0, cus = 0, per_cu = 0;
        hipGetDevice(&dev);
        hipDeviceGetAttribute(&cus, hipDeviceAttributeMultiprocessorCount, dev);
        if (hipFuncSetAttribute((const void*)fwd_kernel, hipFuncAttributeMaxDynamicSharedMemorySize, LDS_BYTES) != hipSuccess) { fprintf(stderr, "kernel_launch: hipFuncSetAttribute failed\n"); }
        if (hipOccupancyMaxActiveBlocksPerMultiprocessor(&per_cu, (const void*)fwd_kernel, NTHREADS, LDS_BYTES) != hipSuccess || per_cu < 1) { fprintf(stderr, "kernel_launch: occupancy query says %d\n", per_cu); per_cu = 1; }
        (void)hipGetLastError();
        grid = cus * 1;
        fprintf(stderr, "kernel_launch: cus %d per_cu %d grid %d\n", cus, per_cu, grid);
    }
    if (grid < 0) return;
    hipMemsetAsync((char*)d_ws + WS_CTL, 0, CTL_BYTES, stream);
    Args a{};
    for (int i = 0; i < 18; ++i) a.in[i] = (const float*)d_in[i];
    a.out = (float*)d_out; a.ws = (unsigned char*)d_ws;
#if MK_MULTI
    for (int ph = 0; ph < 14; ++ph) {
        a.lo = ph; a.hi = ph + 1; a.coop = 0;
        hipLaunchKernelGGL(fwd_kernel, dim3(grid), dim3(NTHREADS), LDS_BYTES, stream, a);
    }
#else
    a.lo = 0; a.hi = 14; a.coop = 1;
    void* kargs[] = {&a};
    hipError_t e = hipLaunchCooperativeKernel((const void*)fwd_kernel, dim3(grid), dim3(NTHREADS), kargs, LDS_BYTES, stream);
    if (e != hipSuccess) fprintf(stderr, "cooperative launch failed: %s (grid %d)\n", hipGetErrorString(e), grid);
#endif
}
```
